# Optimizing an MI355X kernel written in HIP

```python
import numpy as np
import jax
import jax.numpy as jnp
from jax import lax

D_MODEL = 2048
BATCH = 2
SEQ = 4096
DEPTH = 2

HEAD_DIM = 128
NSA_HEADS = 8
NSA_KV_GROUPS = 2
NSA_HPG = NSA_HEADS // NSA_KV_GROUPS
NSA_ROT = HEAD_DIM // 4
CMP_LEN = 32
CMP_STRIDE = 16
SLC_LEN = 64
SLC_TOPK = 16
N_LOCAL_SLC = 2
WINDOW = 512
WIN_BLK = 128
SLC_Q_CHUNK = 64
FORCE_SCORE = 1.0e4

MLA_HEADS = 8
Q_LORA = 768
KV_LORA = 512
QK_NOPE = 128
QK_ROPE = 64
V_HEAD = 128
Q_BLK = 128

ROPE_THETA = 500000.0
EPS = 1e-6

D_FF = 7168
N_EXPERTS = 8
TOP_K = 2
MOE_BLK = 256

IN_SPLITS = (NSA_HEADS * HEAD_DIM,
             3 * 2 * NSA_KV_GROUPS * HEAD_DIM,
             3 * NSA_HEADS,
             Q_LORA,
             KV_LORA,
             QK_ROPE,
             2 * D_MODEL)
D_IN = sum(IN_SPLITS)
IN_SPLIT_POINTS = tuple(int(v) for v in np.cumsum(IN_SPLITS)[:-1])

kernel_name = 'nsa_mla_gated_hybrid_moe'


def rms_norm(x, g):
    xf = x.astype(jnp.float32)
    y = xf * lax.rsqrt(jnp.mean(xf * xf, axis=-1, keepdims=True) + EPS)
    return (y * g.astype(jnp.float32)).astype(x.dtype)


def masked_softmax(s, mask):
    s = jnp.where(mask, s.astype(jnp.float32), -jnp.inf)
    m = jnp.max(s, axis=-1, keepdims=True)
    m = jnp.where(jnp.isfinite(m), m, 0.0)
    p = jnp.exp(s - m)
    den = jnp.sum(p, axis=-1, keepdims=True)
    return p / jnp.where(den > 0.0, den, 1.0)


def rope_tables(pos, rot_dim):
    inv = 1.0 / (ROPE_THETA ** (jnp.arange(0, rot_dim, 2, dtype=jnp.float32) / rot_dim))
    ang = jnp.asarray(pos).astype(jnp.float32)[:, None] * inv[None, :]
    return jnp.cos(ang), jnp.sin(ang)


def rope(x, cos, sin):
    r = cos.shape[-1]
    c = cos[:, None, :].astype(x.dtype)
    s = sin[:, None, :].astype(x.dtype)
    x1, x2 = x[..., :r], x[..., r:]
    return jnp.concatenate([x1 * c - x2 * s, x2 * c + x1 * s], axis=-1)


def partial_rope(x, cos, sin):
    rd = 2 * cos.shape[-1]
    return jnp.concatenate([rope(x[..., :rd], cos, sin), x[..., rd:]], axis=-1)


def compress_blocks(x_tok, pe, w):
    S_ = x_tok.shape[1]
    n_cmp = (S_ - CMP_LEN) // CMP_STRIDE + 1
    idx = np.arange(n_cmp)[:, None] * CMP_STRIDE + np.arange(CMP_LEN)[None, :]
    blocks = x_tok[:, idx] + pe[None, None, :, None, :].astype(x_tok.dtype)
    return jnp.einsum('bnlgd,lde->bnge', blocks, w)


def nsa_mixer(zq, zkv, zg, q_norm_g, k_norm_g, pe_k, pe_v, w_ck, w_cv, rope_tok, rope_cmp):
    B_, S_ = zq.shape[0], zq.shape[1]
    G, Hg, dk = NSA_KV_GROUPS, NSA_HPG, HEAD_DIM
    scale = dk ** -0.5
    t = jnp.arange(S_)
    q = partial_rope(rms_norm(zq.reshape(B_, S_, NSA_HEADS, dk), q_norm_g), *rope_tok)
    qg = q.reshape(B_, S_, G, Hg, dk)
    kv = zkv.reshape(B_, S_, 3, 2, G, dk)

    n_cmp = (S_ - CMP_LEN) // CMP_STRIDE + 1
    cmp_start = np.arange(n_cmp) * CMP_STRIDE
    cmp_end = cmp_start + CMP_LEN - 1
    k_c = partial_rope(rms_norm(compress_blocks(kv[:, :, 0, 0], pe_k, w_ck), k_norm_g[0]), *rope_cmp)
    v_c = compress_blocks(kv[:, :, 0, 1], pe_v, w_cv)
    s_c = jnp.einsum('bsghd,bngd->bghsn', qg, k_c, preferred_element_type=jnp.float32) * scale
    p_c = masked_softmax(s_c, t[:, None] >= jnp.asarray(cmp_end)[None, :])
    o_c = jnp.einsum('bghsn,bngd->bsghd', p_c.astype(v_c.dtype), v_c)

    n_slc = S_ // SLC_LEN
    n_sel = min(SLC_TOPK, n_slc)
    slc_start = np.arange(n_slc) * SLC_LEN
    overlap = ((cmp_start[:, None] <= slc_start[None, :] + SLC_LEN - 1)
               & (slc_start[None, :] <= cmp_end[:, None])).astype(np.float32)
    imp = jnp.einsum('bghsn,nj->bgsj', p_c, jnp.asarray(overlap))
    blk = jnp.arange(n_slc)[None, :]
    cur = (t // SLC_LEN)[:, None]
    forced = (blk == 0) | ((blk <= cur) & (blk > cur - N_LOCAL_SLC))
    imp = jnp.where(blk > cur, -jnp.inf, jnp.where(forced, FORCE_SCORE, imp))
    _, sel = lax.top_k(imp, n_sel)

    k_s = partial_rope(rms_norm(kv[:, :, 1, 0], k_norm_g[1]), *rope_tok).transpose(0, 2, 1, 3)
    v_s = kv[:, :, 1, 1].transpose(0, 2, 1, 3)
    C = SLC_Q_CHUNK
    n_chunk = S_ // C
    q_ch = qg.reshape(B_, n_chunk, C, G, Hg, dk).transpose(1, 0, 3, 2, 4, 5)
    sel_ch = sel.reshape(B_, G, n_chunk, C, n_sel).transpose(2, 0, 1, 3, 4)
    t_ch = t.reshape(n_chunk, C)
    b_ix = jnp.arange(B_)[:, None, None, None]
    g_ix = jnp.arange(G)[None, :, None, None]

    def slc_chunk(args):
        qc, ic, tc = args
        kpos = (ic[..., None] * SLC_LEN + jnp.arange(SLC_LEN)).reshape(B_, G, C, n_sel * SLC_LEN)
        kk = k_s[b_ix, g_ix, kpos]
        vv = v_s[b_ix, g_ix, kpos]
        s = jnp.einsum('bgchd,bgckd->bgchk', qc, kk, preferred_element_type=jnp.float32) * scale
        p = masked_softmax(s, (kpos <= tc[None, None, :, None])[:, :, :, None, :])
        return jnp.einsum('bgchk,bgckd->bgchd', p.astype(vv.dtype), vv)

    o_s = lax.map(slc_chunk, (q_ch, sel_ch, t_ch))
    o_s = o_s.transpose(1, 0, 3, 2, 4, 5).reshape(B_, S_, G, Hg, dk)

    k_w = partial_rope(rms_norm(kv[:, :, 2, 0], k_norm_g[2]), *rope_tok)
    v_w = kv[:, :, 2, 1]
    nb = S_ // WIN_BLK
    halo = WINDOW // WIN_BLK

    def band(a):
        a = jnp.pad(a, ((0, 0), (WINDOW, 0), (0, 0), (0, 0))).reshape(B_, nb + halo, WIN_BLK, G, dk)
        return jnp.concatenate([a[:, i:i + nb] for i in range(halo + 1)], axis=2)

    k_band, v_band = band(k_w), band(v_w)
    q_blk = qg.reshape(B_, nb, WIN_BLK, G, Hg, dk)
    qpos = jnp.arange(nb)[:, None] * WIN_BLK + jnp.arange(WIN_BLK)[None, :]
    kpos = jnp.arange(nb)[:, None] * WIN_BLK - WINDOW + jnp.arange((halo + 1) * WIN_BLK)[None, :]
    dist = qpos[:, :, None] - kpos[:, None, :]
    wmask = (dist >= 0) & (dist < WINDOW) & (kpos[:, None, :] >= 0)
    s_w = jnp.einsum('bnqghd,bnkgd->bnghqk', q_blk, k_band, preferred_element_type=jnp.float32) * scale
    p_w = masked_softmax(s_w, wmask[None, :, None, None])
    o_w = jnp.einsum('bnghqk,bnkgd->bnqghd', p_w.astype(v_band.dtype), v_band).reshape(B_, S_, G, Hg, dk)

    g = jax.nn.sigmoid(zg.astype(jnp.float32)).astype(zq.dtype).reshape(B_, S_, 3, NSA_HEADS, 1)
    o = (g[:, :, 0] * o_c.reshape(B_, S_, NSA_HEADS, dk)
         + g[:, :, 1] * o_s.reshape(B_, S_, NSA_HEADS, dk)
         + g[:, :, 2] * o_w.reshape(B_, S_, NSA_HEADS, dk))
    return o.reshape(B_, S_, NSA_HEADS * dk)


def mla_mixer(zqa, zkva, zkr, qa_norm_g, w_q_b, kva_norm_g, w_kv_b,
              q_norm_g, qr_norm_g, k_norm_g, kr_norm_g, rope_mla):
    B_, S_ = zqa.shape[0], zqa.shape[1]
    H = MLA_HEADS
    scale = (QK_NOPE + QK_ROPE) ** -0.5
    q = (rms_norm(zqa, qa_norm_g) @ w_q_b).reshape(B_, S_, H, QK_NOPE + QK_ROPE)
    q_nope = rms_norm(q[..., :QK_NOPE], q_norm_g)
    q_rope = rope(rms_norm(q[..., QK_NOPE:], qr_norm_g), *rope_mla)
    kv = (rms_norm(zkva, kva_norm_g) @ w_kv_b).reshape(B_, S_, H, QK_NOPE + V_HEAD)
    k_nope = rms_norm(kv[..., :QK_NOPE], k_norm_g)
    v = kv[..., QK_NOPE:]
    k_rope = rope(rms_norm(zkr[:, :, None, :], kr_norm_g), *rope_mla)[:, :, 0]
    nq = S_ // Q_BLK
    kpos = jnp.arange(S_)

    def q_block(args):
        qn, qr, qp = args
        s = (jnp.einsum('bqhd,bkhd->bhqk', qn, k_nope, preferred_element_type=jnp.float32)
             + jnp.einsum('bqhr,bkr->bhqk', qr, k_rope, preferred_element_type=jnp.float32)) * scale
        p = masked_softmax(s, qp[:, None] >= kpos[None, :])
        return jnp.einsum('bhqk,bkhd->bqhd', p.astype(v.dtype), v)

    qn_b = q_nope.reshape(B_, nq, Q_BLK, H, QK_NOPE).transpose(1, 0, 2, 3, 4)
    qr_b = q_rope.reshape(B_, nq, Q_BLK, H, QK_ROPE).transpose(1, 0, 2, 3, 4)
    o = lax.map(q_block, (qn_b, qr_b, kpos.reshape(nq, Q_BLK)))
    return o.transpose(1, 0, 2, 3, 4).reshape(B_, S_, H * V_HEAD)


def swiglu(h, w1, w3, w2):
    return (jax.nn.silu(h @ w1) * (h @ w3)) @ w2


def moe_ffn(h, w_router, w1, w3, w2):
    B_, S_, D = h.shape
    T = B_ * S_
    x = h.reshape(T, D)
    logits = jnp.einsum('td,de->te', x, w_router, preferred_element_type=jnp.float32)
    top_logit, top_idx = lax.top_k(logits, TOP_K)
    gate = jax.nn.softmax(top_logit, axis=-1).astype(x.dtype)
    A = T * TOP_K
    e_flat = top_idx.reshape(A)
    tok_flat = jnp.repeat(jnp.arange(T, dtype=jnp.int32), TOP_K)
    g_flat = gate.reshape(A)
    order = jnp.argsort(e_flat)
    e_sorted = e_flat[order]
    counts = jnp.bincount(e_flat, length=N_EXPERTS)
    padded = (counts + MOE_BLK - 1) // MOE_BLK * MOE_BLK
    start = jnp.cumsum(counts) - counts
    pad_end = jnp.cumsum(padded)
    pad_start = pad_end - padded
    dest = pad_start[e_sorted] + (jnp.arange(A) - start[e_sorted])
    n_blk = -(-A // MOE_BLK) + N_EXPERTS
    n_slot = n_blk * MOE_BLK
    slot_tok = jnp.full((n_slot,), T, jnp.int32).at[dest].set(tok_flat[order])
    slot_gate = jnp.zeros((n_slot,), x.dtype).at[dest].set(g_flat[order])
    blk_exp = jnp.clip(jnp.searchsorted(pad_end, jnp.arange(n_blk) * MOE_BLK, side='right'), 0, N_EXPERTS - 1)
    x_pad = jnp.concatenate([x, jnp.zeros((1, D), x.dtype)], axis=0)
    xb = x_pad[slot_tok].reshape(n_blk, MOE_BLK, D)

    def expert_block(args):
        xe, e = args
        return swiglu(xe, w1[e], w3[e], w2[e])

    yb = lax.map(expert_block, (xb, blk_exp)).reshape(n_slot, D)
    y = jnp.zeros((T + 1, D), x.dtype).at[slot_tok].add(yb * slot_gate[:, None])
    return y[:T].reshape(B_, S_, D)


def setup_inputs(seed: int = 0) -> dict:
    key = jax.random.key(seed)
    ks = iter(jax.random.split(key, 40))
    n_dense = (DEPTH + 1) // 2
    n_moe = DEPTH // 2

    def w(shape, fan_in):
        return jax.random.normal(next(ks), shape, jnp.float32) * (fan_in ** -0.5)

    def gain(shape):
        return 1.0 + 0.02 * jax.random.normal(next(ks), shape, jnp.float32)

    def small(shape, s):
        return s * jax.random.normal(next(ks), shape, jnp.float32)

    return {
        'x': jax.random.normal(next(ks), (BATCH, SEQ, D_MODEL), jnp.float32),
        'attn_norm_g': gain((DEPTH, D_MODEL)),
        'w_in': w((DEPTH, D_MODEL, D_IN), D_MODEL),
        'nsa_q_norm_g': gain((DEPTH, HEAD_DIM)),
        'nsa_k_norm_g': gain((DEPTH, 3, HEAD_DIM)),
        'cmp_pe_k': small((DEPTH, CMP_LEN, HEAD_DIM), 0.1),
        'cmp_pe_v': small((DEPTH, CMP_LEN, HEAD_DIM), 0.1),
        'w_cmp_k': w((DEPTH, CMP_LEN, HEAD_DIM, HEAD_DIM), CMP_LEN * HEAD_DIM),
        'w_cmp_v': w((DEPTH, CMP_LEN, HEAD_DIM, HEAD_DIM), CMP_LEN * HEAD_DIM),
        'mla_qa_norm_g': gain((DEPTH, Q_LORA)),
        'w_q_b': w((DEPTH, Q_LORA, MLA_HEADS * (QK_NOPE + QK_ROPE)), Q_LORA),
        'mla_kva_norm_g': gain((DEPTH, KV_LORA)),
        'w_kv_b': w((DEPTH, KV_LORA, MLA_HEADS * (QK_NOPE + V_HEAD)), KV_LORA),
        'mla_q_norm_g': gain((DEPTH, QK_NOPE)),
        'mla_qr_norm_g': gain((DEPTH, QK_ROPE)),
        'mla_k_norm_g': gain((DEPTH, QK_NOPE)),
        'mla_kr_norm_g': gain((DEPTH, QK_ROPE)),
        'w_proj_nsa': w((DEPTH, NSA_HEADS * HEAD_DIM, D_MODEL), NSA_HEADS * HEAD_DIM),
        'w_proj_mla': w((DEPTH, MLA_HEADS * V_HEAD, D_MODEL), MLA_HEADS * V_HEAD),
        'w_out': w((DEPTH, D_MODEL, D_MODEL), D_MODEL),
        'ffn_norm_g': gain((DEPTH, D_MODEL)),
        'w_ff1': w((n_dense, D_MODEL, D_FF), D_MODEL),
        'w_ff3': w((n_dense, D_MODEL, D_FF), D_MODEL),
        'w_ff2': w((n_dense, D_FF, D_MODEL), D_FF),
        'w_router': w((n_moe, D_MODEL, N_EXPERTS), D_MODEL),
        'w_e1': w((n_moe, N_EXPERTS, D_MODEL, D_FF), D_MODEL),
        'w_e3': w((n_moe, N_EXPERTS, D_MODEL, D_FF), D_MODEL),
        'w_e2': w((n_moe, N_EXPERTS, D_FF, D_MODEL), D_FF),
    }


def reference(x, attn_norm_g, w_in, nsa_q_norm_g, nsa_k_norm_g, cmp_pe_k, cmp_pe_v, w_cmp_k, w_cmp_v,
              mla_qa_norm_g, w_q_b, mla_kva_norm_g, w_kv_b, mla_q_norm_g, mla_qr_norm_g, mla_k_norm_g,
              mla_kr_norm_g, w_proj_nsa, w_proj_mla, w_out, ffn_norm_g, w_ff1, w_ff3, w_ff2,
              w_router, w_e1, w_e3, w_e2):
    S_ = x.shape[1]
    pos = jnp.arange(S_)
    n_cmp = (S_ - CMP_LEN) // CMP_STRIDE + 1
    rope_tok = rope_tables(pos, NSA_ROT)
    rope_cmp = rope_tables(jnp.arange(n_cmp) * CMP_STRIDE + CMP_LEN - 1, NSA_ROT)
    rope_mla = rope_tables(pos, QK_ROPE)
    for l in range(DEPTH):
        h = rms_norm(x, attn_norm_g[l])
        z = h @ w_in[l]
        zq, zkv, zg, zqa, zkva, zkr, zm = jnp.split(z, IN_SPLIT_POINTS, axis=-1)
        o_a = nsa_mixer(zq, zkv, zg, nsa_q_norm_g[l], nsa_k_norm_g[l], cmp_pe_k[l], cmp_pe_v[l],
                        w_cmp_k[l], w_cmp_v[l], rope_tok, rope_cmp)
        o_b = mla_mixer(zqa, zkva, zkr, mla_qa_norm_g[l], w_q_b[l], mla_kva_norm_g[l], w_kv_b[l],
                        mla_q_norm_g[l], mla_qr_norm_g[l], mla_k_norm_g[l], mla_kr_norm_g[l], rope_mla)
        gm = jax.nn.sigmoid(zm.astype(jnp.float32)).astype(x.dtype)
        mix = gm[..., :D_MODEL] * (o_a @ w_proj_nsa[l]) + gm[..., D_MODEL:] * (o_b @ w_proj_mla[l])
        x = x + mix @ w_out[l]
        h = rms_norm(x, ffn_norm_g[l])
        if l % 2 == 0:
            x = x + swiglu(h, w_ff1[l // 2], w_ff3[l // 2], w_ff2[l // 2])
        else:
            x = x + moe_ffn(h, w_router[l // 2], w_e1[l // 2], w_e3[l // 2], w_e2[l // 2])
    return x
```

```cpp
#include <hip/hip_runtime.h>
#include <cstdio>
#include <cstdint>
#include <cstring>

#ifndef REPEAT_MASK
#define REPEAT_MASK 0
#endif
#define NREP(bit) (1 + ((REPEAT_MASK >> (bit)) & 1))
#ifndef MK_ONE_LAUNCH
#define MK_ONE_LAUNCH 1
#endif

#define GAS __attribute__((address_space(1)))
#define LAS __attribute__((address_space(3)))
typedef unsigned short bf16;
typedef short bf16x8 __attribute__((ext_vector_type(8)));
typedef short s16x4 __attribute__((ext_vector_type(4)));
typedef float f32x4 __attribute__((ext_vector_type(4)));
typedef float f32x16 __attribute__((ext_vector_type(16)));
typedef unsigned u32x4 __attribute__((ext_vector_type(4)));
typedef unsigned u32x2 __attribute__((ext_vector_type(2)));
typedef unsigned long long u64;

constexpr int BATCH = 2, SEQ = 4096, T = BATCH * SEQ, DM = 2048;
constexpr int HD = 128, NH = 8, NG = 2;
constexpr int QLORA = 768, KVLORA = 512, MH = 8;
constexpr int DFF = 7168, NE = 8;
constexpr int DIN = 8024, DINP = 8192;
constexpr int ZQ = 0, ZKV = 1024, ZQA = 2560, ZKVA = 3328, ZKR = 3840, ZG = 3904, ZM = 4096;
constexpr float EPS = 1e-6f;
constexpr int NSLOT_MAX = 72 * 256;
constexpr int NPH = 28;

constexpr size_t MiB = 1u << 20;
constexpr size_t WS_CTL = 0, CTL_BYTES = 1 * MiB;
constexpr size_t WS_TAB = 1 * MiB;
constexpr size_t TAB_COS_TOK = 0, TAB_SIN_TOK = 256 * 1024, TAB_COS_MLA = 512 * 1024, TAB_SIN_MLA = 1024 * 1024,
                 TAB_COS_CMP = 1536 * 1024, TAB_SIN_CMP = 1536 * 1024 + 16384, TAB_ORDER = 1536 * 1024 + 32768, TAB_ROUTE = 2 * MiB  ,
                 TAB_SLOTTOK = 2 * MiB + 128 * 1024  , TAB_SLOTGATE = 2 * MiB + 256 * 1024, TAB_BLKEXP = 2 * MiB + 384 * 1024  ,
                 TAB_SELMASK = 2 * MiB + 512 * 1024  , TAB_TOKSLOT = 2 * MiB + 640 * 1024  ;
constexpr size_t WS_WL = 4 * MiB;
constexpr size_t WL_STRIDE = 56 * MiB;
constexpr size_t WL_IN = 0, WL_QB = 32 * MiB, WL_KVB = 35 * MiB, WL_CK = 37 * MiB, WL_CV = 38 * MiB, WL_PA = 39 * MiB, WL_PB = 43 * MiB, WL_OUT = 47 * MiB;
constexpr size_t WS_W13D = WS_WL + 2 * WL_STRIDE;
constexpr size_t WS_W2D = WS_W13D + 56 * MiB;
constexpr size_t WS_W13E = WS_W2D + 28 * MiB;
constexpr size_t WS_W2E = WS_W13E + 448 * MiB;
constexpr size_t WS_ZA = WS_W2E + 224 * MiB;
constexpr size_t WS_H = WS_ZA;
constexpr size_t WS_Z = WS_ZA;
constexpr size_t WS_QRAW = WS_ZA + 128 * MiB;
constexpr size_t WS_KVRAW = WS_QRAW + 24 * MiB;
constexpr size_t WS_QM = WS_KVRAW + 32 * MiB;
constexpr size_t WS_KM = WS_QM + 24 * MiB;
constexpr size_t WS_VM = WS_KM + 16 * MiB;
constexpr size_t WS_ZB = WS_ZA + 252 * MiB;
constexpr size_t WS_HN = WS_ZB;
constexpr size_t WS_AG = WS_HN + 32 * MiB;
constexpr size_t WS_X1 = WS_AG + 72 * MiB;
constexpr size_t WS_XA = WS_X1 + 64 * MiB;
constexpr size_t WS_MIX1 = WS_XA + 64 * MiB;
constexpr size_t WS_MIX = WS_MIX1 + 64 * MiB;
constexpr size_t WS_QN = WS_MIX + 32 * MiB;
constexpr size_t WS_NSAKV = WS_QN + 16 * MiB;
constexpr size_t NSAKV_ONE = (size_t)BATCH * NG * SEQ * HD * 2;
constexpr size_t WS_QAN = WS_NSAKV + 24 * MiB;
constexpr size_t WS_KVAN = WS_QAN + 12 * MiB;
constexpr size_t WS_KR = WS_KVAN + 8 * MiB;
constexpr size_t WS_GNSA = WS_KR + 1 * MiB;
constexpr size_t WS_KC = WS_GNSA + 1 * MiB;
constexpr size_t WS_VC = WS_KC + 512 * 1024;
constexpr size_t WS_OC = WS_KC + 1 * MiB;
constexpr size_t WS_OS = WS_OC + 16 * MiB, WS_OW = WS_OS + 16 * MiB;
constexpr size_t WS_OA = WS_OW + 16 * MiB, WS_OB = WS_OA + 16 * MiB;
constexpr size_t WS_END = WS_OB + 16 * MiB;
constexpr size_t WS_SSP = WS_END;
constexpr size_t WS_SSQ = WS_SSP + 2 * MiB;
constexpr size_t WS_SSKV = WS_SSQ + 512 * 1024;
constexpr size_t WS_END2 = WS_SSQ + 1 * MiB;
constexpr size_t WS_Y0 = WS_HN;
constexpr size_t WS_YT = WS_MIX1;
static_assert(WS_Y0 + (size_t)NSLOT_MAX * DM * 4 <= WS_XA, "Y0 overlay");

constexpr int CW_BAR = 4096;
constexpr int CW_QUEUE = 16384;
constexpr int CW_SS = 32768;
#ifndef CONV_LIMIT
#define CONV_LIMIT 96
#endif

constexpr int RING_BYTES = 131072, MISC_OFF = RING_BYTES + 320, LDS_BYTES = 147456;

__device__ __forceinline__ unsigned cvt_pk_bf16(float lo, float hi) { unsigned r; asm volatile("v_cvt_pk_bf16_f32 %0, %1, %2" : "=v"(r) : "v"(lo), "v"(hi)); return r; }
__device__ __forceinline__ float bf2f(unsigned short b) { return __uint_as_float(((unsigned)b) << 16); }
__device__ __forceinline__ float bflo(unsigned w) { return __uint_as_float(w << 16); }
__device__ __forceinline__ float bfhi(unsigned w) { return __uint_as_float(w & 0xffff0000u); }
__device__ __forceinline__ int lane_id_fresh() { int l; asm volatile("v_mbcnt_lo_u32_b32 %0, -1, 0\n\tv_mbcnt_hi_u32_b32 %0, -1, %0" : "=v"(l)); return l; }
__device__ __forceinline__ int fresh_tid(int wv) { return (wv << 6) | lane_id_fresh(); }
template <class T> __device__ __forceinline__ T shx(T v, int m) { static_assert(sizeof(T) == 4, "32-bit only"); return __builtin_bit_cast(T, __builtin_amdgcn_ds_bpermute((lane_id_fresh() ^ m) << 2, __builtin_bit_cast(int, v))); }
__device__ __forceinline__ float wave_sum(float v) {
#pragma unroll
    for (int o = 1; o < 64; o <<= 1) v += shx(v, o);
    return v;
}
__device__ __forceinline__ float fexp2(float x) { return __builtin_amdgcn_exp2f(x); }
__device__ __forceinline__ float fma_s(float a, float b, float c) { float r; asm("v_fma_f32 %0, %1, %2, %3" : "=v"(r) : "v"(a), "v"(b), "v"(c)); return r; }
__device__ __forceinline__ void pair32(float x, float& a, float& b) { a = x; b = x; asm volatile("s_nop 1\n\tv_permlane32_swap_b32 %0, %1" : "+v"(a), "+v"(b)); }
__device__ __forceinline__ float sum4x(float x) { float a = x, b = x; asm volatile("s_nop 1\n\tv_permlane16_swap_b32 %0, %1" : "+v"(a), "+v"(b)); x = a + b; a = x; b = x; asm volatile("s_nop 1\n\tv_permlane32_swap_b32 %0, %1" : "+v"(a), "+v"(b)); return a + b; }
__device__ __forceinline__ float add_s(float a, float b) { float r; asm("v_add_f32 %0, %1, %2" : "=v"(r) : "v"(a), "v"(b)); return r; }
__device__ __forceinline__ float frcp(float x) { return __builtin_amdgcn_rcpf(x); }
__device__ __forceinline__ float sigmoidf_(float x) { return frcp(1.0f + fexp2(-1.4426950408889634f * x)); }
__device__ __forceinline__ void unpack8(u32x4 w, float (&v)[8]) { v[0] = bflo(w.x); v[1] = bfhi(w.x); v[2] = bflo(w.y); v[3] = bfhi(w.y); v[4] = bflo(w.z); v[5] = bfhi(w.z); v[6] = bflo(w.w); v[7] = bfhi(w.w); }
__device__ __forceinline__ u32x4 pack8f(const float* v) { u32x4 w; w.x = cvt_pk_bf16(v[0], v[1]); w.y = cvt_pk_bf16(v[2], v[3]); w.z = cvt_pk_bf16(v[4], v[5]); w.w = cvt_pk_bf16(v[6], v[7]); return w; }

typedef int v4i_t __attribute__((ext_vector_type(4)));
typedef int v8i_t __attribute__((ext_vector_type(8)));
__device__ __forceinline__ float f8_clamp(float v) { return __builtin_fminf(__builtin_fmaxf(v, -448.f), 448.f); }
__device__ __forceinline__ unsigned pk4_f8(float a, float b, float c, float d) { int w = __builtin_amdgcn_cvt_pk_fp8_f32(f8_clamp(a), f8_clamp(b), 0, false); w = __builtin_amdgcn_cvt_pk_fp8_f32(f8_clamp(c), f8_clamp(d), w, true); return (unsigned)w; }
__device__ __forceinline__ void rope_cs(float pos, int k, float kscale, float& c, float& sn) {
    const float inv = __builtin_amdgcn_exp2f(-(float)k * kscale), rev = pos * inv * 0.15915494309189535f, fr = __builtin_amdgcn_fractf(rev);
    c = __builtin_amdgcn_cosf(fr); sn = __builtin_amdgcn_sinf(fr); }
constexpr float ROPE_L2T = 18.931568569324174f;
constexpr int F8_W13_EXP = 11, F8_W2_EXP = 12;
constexpr float F8_A_SCALE = 16.f, F8_H_SCALE = 8.f;
namespace pg8 {
constexpr int BM = 256, BK = 64, HALF = 128, HTB = HALF * BK * 2, STAGE_BYTES = 8 * HTB, NXCD = 8, WGM = 8;
__host__ __device__ __forceinline__ int lds_byte(int r, int c) { const int st = (r >> 4) * 2 + (c >> 5), rr = r & 15, cc = c & 31, ob = rr * 64 + cc * 2; return st * 1024 + (ob ^ (((ob >> 9) & 1) << 5)); }
__host__ __device__ __forceinline__ void stage_rc(int b, int& R, int& C) { const int st = b / 1024, sb = b % 1024, swz = sb ^ (((sb >> 9) & 1) << 5); R = (st >> 1) * 16 + swz / 64; C = (st & 1) * 32 + (swz % 64) / 2; }
__host__ __device__ __forceinline__ int perm32(int rho) { const int n = rho >> 4, i = rho & 15; return 8 * (i >> 2) + 4 * n + (i & 3); }

template <int ES> struct Frag;
template <> struct Frag<2> { bf16x8 k[2]; };
template <> struct Frag<1> { v8i_t v; };
struct Unit { int pm, pn, kofs, nt, kidx, tail; };
struct Gemm { const bf16* A; int lda; const bf16* Bt; int K; };

struct Order {
    int nM, nN, nwg, G, c; const int* blk_exp; size_t estride; int nt_full, n_full, ks, es, rot;
    static __device__ __forceinline__ void tail_params(int nwg, int G, int nt_full, int& n_full, int& ks) {
        n_full = nwg; ks = 1;
        const int nf = (nwg / G) * G, r = nwg - nf; if (r > 0) { int s = G / r; s = s > 4 ? 4 : s; while (s > 1 && (nt_full % (2 * s)) != 0) --s; if (s > 1) { n_full = nf; ks = s; } } }
    __device__ __forceinline__ void init(int nM_, int nN_, int G_, int c_, int K, const int* be = nullptr, size_t estr = 0, bool tail_split = false, int es_ = 2) { nM = nM_; nN = nN_; nwg = nM * nN; G = G_; c = c_; blk_exp = be; estride = estr; es = es_; rot = 0;
        nt_full = K * es_ / 128; n_full = nwg; ks = 1;
        if (tail_split) tail_params(nwg, G, nt_full, n_full, ks); }
    static __device__ __forceinline__ int tile_wgid(int nM, int nN, int pm, int pn) { const int gid = pm / WGM, fm = gid * WGM, gsz = (nM - fm) < WGM ? (nM - fm) : WGM; return gid * (WGM * nN) + pn * gsz + (pm - fm); }
    __device__ __forceinline__ bool next(int i, Unit& u) const {
        const long L = (long)i * G + c; int wgid; u.kofs = 0; u.nt = nt_full; u.kidx = 0; u.tail = 0;
        if (L < n_full) { wgid = (int)L; const int q = n_full / NXCD, r = n_full % NXCD, xcd = wgid % NXCD, off = wgid / NXCD; wgid = (xcd < r ? xcd * (q + 1) : r * (q + 1) + (xcd - r) * q) + off; }
        else { const long Ls = L - n_full; const long ui = n_full + Ls / ks; if (ui >= nwg) return false; wgid = (int)ui; u.nt = nt_full / ks; u.kidx = (int)(Ls % ks); u.kofs = u.kidx * u.nt; u.tail = wgid - n_full; }
        const int nig = WGM * nN, gid = wgid / nig, fm = gid * WGM, gsz = (nM - fm) < WGM ? (nM - fm) : WGM;
        u.pm = fm + ((wgid % nig) % gsz); u.pn = (wgid % nig) / gsz; if (rot && (i & 1)) { u.pn += nN >> 1; if (u.pn >= nN) u.pn -= nN; } return true;
    }
    __device__ __forceinline__ void ptrs(const Gemm& g, const Unit& u, const char*& a, const char*& b) const {
        a = (const char*)g.A + (size_t)u.pm * 256 * g.lda * es + (size_t)u.kofs * 128;
        b = (const char*)g.Bt + (size_t)u.pn * 256 * g.K * es + (size_t)u.kofs * 128 + (blk_exp ? (size_t)__builtin_amdgcn_readfirstlane(blk_exp[u.pm]) * estride : (size_t)0);
    }
};

template <int NP> __device__ __forceinline__ void row_rs8(const float* ssp, int row0, int fq, float (&rs)[2][4], float inv_n) {
    if (!ssp) {
#pragma unroll
        for (int ai = 0; ai < 2; ++ai)
#pragma unroll
            for (int m = 0; m < 4; ++m) rs[ai][m] = 1.0f;
        return; }
    constexpr int PER = NP / 4;
    float a[2][4][PER];
#pragma unroll
    for (int ai = 0; ai < 2; ++ai)
#pragma unroll
        for (int m = 0; m < 4; ++m) { const float* p = ssp + (size_t)(row0 + ai * 128 + m * 16) * NP + fq * PER;
#pragma unroll
            for (int i = 0; i < PER; ++i) a[ai][m][i] = p[i]; }
#pragma unroll
    for (int ai = 0; ai < 2; ++ai)
#pragma unroll
        for (int m = 0; m < 4; ++m) { float s = a[ai][m][0];
#pragma unroll
            for (int i = 1; i < PER; ++i) s += a[ai][m][i];
            s = sum4x(s); rs[ai][m] = __builtin_amdgcn_rsqf(s * inv_n + EPS); }
}
template <int NP> struct EpiBf16 {
    static constexpr bool PERM = true, MID = false;
    bf16* O; int ldc; const float* ss; float inv_n;
    __device__ __forceinline__ void operator()(const f32x4 (&acc)[2][2][4][2], const Unit& u, int wr, int wc, int fr, int fq) const {
        const int row0 = u.pm * BM + wr * 64 + fr, col0 = u.pn * BM + wc * 32 + 8 * fq;
        float rsv[2][4]; row_rs8<NP>(ss, row0, fq, rsv, inv_n);
#pragma unroll
        for (int ai = 0; ai < 2; ++ai)
#pragma unroll
            for (int m = 0; m < 4; ++m) { bf16* rowp = O + (size_t)(row0 + ai * HALF + m * 16) * ldc + col0;
                const float rs = rsv[ai][m];
#pragma unroll
                for (int bj = 0; bj < 2; ++bj) { const f32x4 v0 = acc[ai][bj][m][0] * rs, v1 = acc[ai][bj][m][1] * rs;
                    u32x4 w; w.x = cvt_pk_bf16(v0[0], v0[1]); w.y = cvt_pk_bf16(v0[2], v0[3]); w.z = cvt_pk_bf16(v1[0], v1[1]); w.w = cvt_pk_bf16(v1[2], v1[3]);
                    *(u32x4*)(rowp + bj * HALF) = w; } }
    }
};
struct EpiQb {
    static constexpr bool PERM = true, MID = false;
    bf16* Qm; const float* ss; const float* gn128; const float* gr64; const float* cosM; const float* sinM; LAS float* X;
    __device__ __forceinline__ void operator()(const f32x4 (&acc)[2][2][4][2], const Unit& u, int wr, int wc, int fr, int fq) const {
        int rl0 = wr * 64 + fr, colw = wc * 32 + 8 * fq; asm volatile("" : "+v"(rl0), "+v"(colw));
        const int row0 = u.pm * BM + rl0, pn = u.pn;
        float rsv[2][4]; row_rs8<12>(ss, row0, fq, rsv, 1.0f / QLORA);
#pragma unroll
        for (int ai = 0; ai < 2; ++ai)
#pragma unroll
            for (int m = 0; m < 4; ++m) { const float rs = rsv[ai][m];
#pragma unroll
                for (int bj = 0; bj < 2; ++bj) { const f32x4 v0 = acc[ai][bj][m][0] * rs, v1 = acc[ai][bj][m][1] * rs;
                    float sq = ((v0[0] * v0[0] + v0[1] * v0[1]) + (v0[2] * v0[2] + v0[3] * v0[3])) + ((v1[0] * v1[0] + v1[1] * v1[1]) + (v1[2] * v1[2] + v1[3] * v1[3]));
                    sq = sum4x(sq);
                    if (fq == 0) X[(bj * 256 + rl0 + ai * HALF + m * 16) * 4 + wc] = sq; } }
        asm volatile("s_waitcnt lgkmcnt(0)" ::: "memory"); __builtin_amdgcn_s_barrier(); asm volatile("" ::: "memory");
        const int b = (u.pm * BM) / SEQ;
        if (pn < 4) {
            const f32x4 g0 = *(const f32x4*)(gn128 + colw), g1 = *(const f32x4*)(gn128 + colw + 4);
#pragma unroll
            for (int ai = 0; ai < 2; ++ai)
#pragma unroll
                for (int m = 0; m < 4; ++m) { const int rl = rl0 + ai * HALF + m * 16, row = u.pm * BM + rl; const float rs = rsv[ai][m];
#pragma unroll
                    for (int bj = 0; bj < 2; ++bj) { const f32x4 t4 = *(const LAS f32x4*)(X + (bj * 256 + rl) * 4);
                        const float rn = __builtin_amdgcn_rsqf(((t4[0] + t4[1]) + (t4[2] + t4[3])) * (1.0f / 128.0f) + EPS);
                        const f32x4 y0 = acc[ai][bj][m][0] * (rs * rn) * g0, y1 = acc[ai][bj][m][1] * (rs * rn) * g1;
                        u32x4 w; w.x = cvt_pk_bf16(y0[0], y0[1]); w.y = cvt_pk_bf16(y0[2], y0[3]); w.z = cvt_pk_bf16(y1[0], y1[1]); w.w = cvt_pk_bf16(y1[2], y1[3]);
                        *(u32x4*)(Qm + ((size_t)row * 8 + 2 * pn + bj) * 192 + colw) = w; } asm volatile("" ::: "memory"); }
        } else {
            const int w2 = wc & 1, dimb = 16 * w2 + 8 * (fq & 1) + 32 * (fq >> 1), ib = 16 * w2 + 8 * (fq & 1);
            const f32x4 g0 = *(const f32x4*)(gr64 + dimb), g1 = *(const f32x4*)(gr64 + dimb + 4);
#pragma unroll
            for (int ai = 0; ai < 2; ++ai)
#pragma unroll
                for (int m = 0; m < 4; ++m) { const int rl = rl0 + ai * HALF + m * 16, row = u.pm * BM + rl, sp = row - b * SEQ; const float rs = rsv[ai][m];
                    const f32x4 c0 = *(const f32x4*)(cosM + sp * 32 + ib), c1 = *(const f32x4*)(cosM + sp * 32 + ib + 4), s0 = *(const f32x4*)(sinM + sp * 32 + ib), s1 = *(const f32x4*)(sinM + sp * 32 + ib + 4);
#pragma unroll
                    for (int bj = 0; bj < 2; ++bj) { const LAS float* xp = X + (bj * 256 + rl) * 4 + (wc & 2);
                        const float rn = __builtin_amdgcn_rsqf((xp[0] + xp[1]) * (1.0f / 64.0f) + EPS);
                        f32x4 y0 = acc[ai][bj][m][0] * (rs * rn) * g0, y1 = acc[ai][bj][m][1] * (rs * rn) * g1, p0, p1;
#pragma unroll
                        for (int e = 0; e < 4; ++e) { p0[e] = shx(y0[e], 32); p1[e] = shx(y1[e], 32); }
                        if (fq < 2) { y0 = y0 * c0 - p0 * s0; y1 = y1 * c1 - p1 * s1; } else { y0 = y0 * c0 + p0 * s0; y1 = y1 * c1 + p1 * s1; }
                        u32x4 w; w.x = cvt_pk_bf16(y0[0], y0[1]); w.y = cvt_pk_bf16(y0[2], y0[3]); w.z = cvt_pk_bf16(y1[0], y1[1]); w.w = cvt_pk_bf16(y1[2], y1[3]);
                        const int head = 4 * (pn - 4) + 2 * bj + (wc >> 1);
                        *(u32x4*)(Qm + ((size_t)row * 8 + head) * 192 + 128 + dimb) = w; } asm volatile("" ::: "memory"); }
        }
    }
};
struct EpiKvb {
    static constexpr bool PERM = true, MID = false;
    bf16* Km; bf16* Vm; const float* ss; const float* gk; LAS float* X;
    __device__ __forceinline__ void operator()(const f32x4 (&acc)[2][2][4][2], const Unit& u, int wr, int wc, int fr, int fq) const {
        int rl0 = wr * 64 + fr, colw = wc * 32 + 8 * fq; asm volatile("" : "+v"(rl0), "+v"(colw));
        const int row0 = u.pm * BM + rl0;
        float rsv[2][4]; row_rs8<8>(ss, row0, fq, rsv, 1.0f / KVLORA);
#pragma unroll
        for (int ai = 0; ai < 2; ++ai)
#pragma unroll
            for (int m = 0; m < 4; ++m) { const float rs = rsv[ai][m]; const f32x4 v0 = acc[ai][0][m][0] * rs, v1 = acc[ai][0][m][1] * rs;
                float sq = ((v0[0] * v0[0] + v0[1] * v0[1]) + (v0[2] * v0[2] + v0[3] * v0[3])) + ((v1[0] * v1[0] + v1[1] * v1[1]) + (v1[2] * v1[2] + v1[3] * v1[3]));
                sq = sum4x(sq);
                if (fq == 0) X[(rl0 + ai * HALF + m * 16) * 4 + wc] = sq; }
        asm volatile("s_waitcnt lgkmcnt(0)" ::: "memory"); __builtin_amdgcn_s_barrier(); asm volatile("" ::: "memory");
        const int b = (u.pm * BM) / SEQ;
        const f32x4 g0 = *(const f32x4*)(gk + colw), g1 = *(const f32x4*)(gk + colw + 4);
#pragma unroll
        for (int ai = 0; ai < 2; ++ai)
#pragma unroll
            for (int m = 0; m < 4; ++m) { const int rl = rl0 + ai * HALF + m * 16, row = u.pm * BM + rl, sp = row - b * SEQ; const float rs = rsv[ai][m];
                const f32x4 t4 = *(const LAS f32x4*)(X + rl * 4); const float rn = __builtin_amdgcn_rsqf(((t4[0] + t4[1]) + (t4[2] + t4[3])) * (1.0f / 128.0f) + EPS);
                const size_t hm = (((size_t)b * 8 + u.pn) * SEQ + sp) * 128 + colw;
                { const f32x4 y0 = acc[ai][0][m][0] * (rs * rn) * g0, y1 = acc[ai][0][m][1] * (rs * rn) * g1;
                  u32x4 w; w.x = cvt_pk_bf16(y0[0], y0[1]); w.y = cvt_pk_bf16(y0[2], y0[3]); w.z = cvt_pk_bf16(y1[0], y1[1]); w.w = cvt_pk_bf16(y1[2], y1[3]); *(u32x4*)(Km + hm) = w; }
                { const f32x4 y0 = acc[ai][1][m][0] * rs, y1 = acc[ai][1][m][1] * rs;
                  u32x4 w; w.x = cvt_pk_bf16(y0[0], y0[1]); w.y = cvt_pk_bf16(y0[2], y0[3]); w.z = cvt_pk_bf16(y1[0], y1[1]); w.w = cvt_pk_bf16(y1[2], y1[3]); *(u32x4*)(Vm + hm) = w; } asm volatile("" ::: "memory"); }
    }
};
struct EpiInProj {
    static constexpr bool PERM = true, MID = false;
    bf16* Z; const float* ssin; bf16* Qn; unsigned char* nsakv; float* ssq; float* sskv; const float* qg; const float* kg; const float* cosT; const float* sinT; LAS float* X;
    bf16* Kr; float* gn; const float* krg; const float* cosM; const float* sinM;
    __device__ __forceinline__ void operator()(const f32x4 (&acc)[2][2][4][2], const Unit& u, int wr, int wc, int fr, int fq) const {
        int rl0 = wr * 64 + fr, colw = wc * 32 + 8 * fq; asm volatile("" : "+v"(rl0), "+v"(colw));
        const int row0 = u.pm * BM + rl0, pn = u.pn;
        float rsv[2][4]; row_rs8<32>(ssin, row0, fq, rsv, 1.0f / DM);
        if (pn == 15) {
            if (wc < 2) {
#pragma unroll
                for (int ai = 0; ai < 2; ++ai)
#pragma unroll
                    for (int m = 0; m < 4; ++m) { const float rs = rsv[ai][m]; const f32x4 v0 = acc[ai][0][m][0] * rs, v1 = acc[ai][0][m][1] * rs;
                        float sq = ((v0[0] * v0[0] + v0[1] * v0[1]) + (v0[2] * v0[2] + v0[3] * v0[3])) + ((v1[0] * v1[0] + v1[1] * v1[1]) + (v1[2] * v1[2] + v1[3] * v1[3]));
                        sq = sum4x(sq);
                        if (fq == 0) X[(rl0 + ai * HALF + m * 16) * 4 + wc] = sq; } }
            asm volatile("s_waitcnt lgkmcnt(0)" ::: "memory"); __builtin_amdgcn_s_barrier(); asm volatile("" ::: "memory");
            const int b15 = (u.pm * BM) / SEQ;
            if (wc < 2) { const int dimb = 16 * wc + 8 * (fq & 1) + 32 * (fq >> 1), ib = 16 * wc + 8 * (fq & 1);
                const f32x4 g0 = *(const f32x4*)(krg + dimb), g1 = *(const f32x4*)(krg + dimb + 4);
#pragma unroll
                for (int ai = 0; ai < 2; ++ai)
#pragma unroll
                    for (int m = 0; m < 4; ++m) { const int rl = rl0 + ai * HALF + m * 16, row = u.pm * BM + rl, sp = row - b15 * SEQ; const float rs = rsv[ai][m];
                        const float rn = __builtin_amdgcn_rsqf((X[rl * 4] + X[rl * 4 + 1]) * (1.0f / 64.0f) + EPS);
                        f32x4 c0, c1, s0, s1; { const float fp = (float)sp;
#pragma unroll
                            for (int e = 0; e < 4; ++e) { float ca, sa, cb, sb; rope_cs(fp, ib + e, ROPE_L2T / 32.0f, ca, sa); rope_cs(fp, ib + 4 + e, ROPE_L2T / 32.0f, cb, sb); c0[e] = ca; s0[e] = sa; c1[e] = cb; s1[e] = sb; } }
                        f32x4 y0 = acc[ai][0][m][0] * (rs * rn) * g0, y1 = acc[ai][0][m][1] * (rs * rn) * g1, p0, p1;
#pragma unroll
                        for (int e = 0; e < 4; ++e) { p0[e] = shx(y0[e], 32); p1[e] = shx(y1[e], 32); }
                        if (fq < 2) { y0 = y0 * c0 - p0 * s0; y1 = y1 * c1 - p1 * s1; } else { y0 = y0 * c0 + p0 * s0; y1 = y1 * c1 + p1 * s1; }
                        u32x4 w; w.x = cvt_pk_bf16(y0[0], y0[1]); w.y = cvt_pk_bf16(y0[2], y0[3]); w.z = cvt_pk_bf16(y1[0], y1[1]); w.w = cvt_pk_bf16(y1[2], y1[3]);
                        *(u32x4*)(Kr + (size_t)row * 64 + dimb) = w; asm volatile("" ::: "memory"); } }
            else if (wc == 2 && fq < 3) {
#pragma unroll
                for (int ai = 0; ai < 2; ++ai)
#pragma unroll
                    for (int m = 0; m < 4; ++m) { const int row = row0 + ai * HALF + m * 16; const float rs = rsv[ai][m]; f32x4 o0, o1;
#pragma unroll
                        for (int e = 0; e < 4; ++e) { o0[e] = sigmoidf_(acc[ai][0][m][0][e] * rs); o1[e] = sigmoidf_(acc[ai][0][m][1][e] * rs); }
                        float* gp = gn + (size_t)row * 24 + 8 * fq; *(f32x4*)gp = o0; *(f32x4*)(gp + 4) = o1; } }
            return;
        }
        if (pn >= 10) {
#pragma unroll
            for (int ai = 0; ai < 2; ++ai)
#pragma unroll
                for (int m = 0; m < 4; ++m) { const int row = row0 + ai * HALF + m * 16; const float rs = rsv[ai][m]; float sq = 0.f;
#pragma unroll
                    for (int bj = 0; bj < 2; ++bj) { const f32x4 v0 = acc[ai][bj][m][0] * rs, v1 = acc[ai][bj][m][1] * rs;
                        u32x4 w; w.x = cvt_pk_bf16(v0[0], v0[1]); w.y = cvt_pk_bf16(v0[2], v0[3]); w.z = cvt_pk_bf16(v1[0], v1[1]); w.w = cvt_pk_bf16(v1[2], v1[3]);
                        *(u32x4*)(Z + (size_t)row * DINP + pn * BM + bj * HALF + colw) = w;
                        sq += ((v0[0] * v0[0] + v0[1] * v0[1]) + (v0[2] * v0[2] + v0[3] * v0[3])) + ((v1[0] * v1[0] + v1[1] * v1[1]) + (v1[2] * v1[2] + v1[3] * v1[3])); }
                    if (pn < 15) { sq = sum4x(sq);
                        if (fq == 0) { if (pn < 13) ssq[(size_t)row * 12 + (pn - 10) * 4 + wc] = sq; else sskv[(size_t)row * 8 + (pn - 13) * 4 + wc] = sq; } } }
            return;
        }
        const bool do_norm = (pn < 4) || (pn == 6) || (pn == 8);
        const float* gvec = (pn < 4) ? qg : kg + ((pn - 4) >> 1) * 128;
        if (do_norm) {
#pragma unroll
            for (int ai = 0; ai < 2; ++ai)
#pragma unroll
                for (int m = 0; m < 4; ++m) { const float rs = rsv[ai][m];
#pragma unroll
                    for (int bj = 0; bj < 2; ++bj) { const f32x4 v0 = acc[ai][bj][m][0] * rs, v1 = acc[ai][bj][m][1] * rs;
                        float sq = ((v0[0] * v0[0] + v0[1] * v0[1]) + (v0[2] * v0[2] + v0[3] * v0[3])) + ((v1[0] * v1[0] + v1[1] * v1[1]) + (v1[2] * v1[2] + v1[3] * v1[3]));
                        sq = sum4x(sq);
                        if (fq == 0) X[(bj * 256 + rl0 + ai * HALF + m * 16) * 4 + wc] = sq; } }
            asm volatile("s_waitcnt lgkmcnt(0)" ::: "memory"); __builtin_amdgcn_s_barrier(); asm volatile("" ::: "memory");
        }
        const int b = (u.pm * BM) / SEQ;
        f32x4 gv[2]; gv[0] = (f32x4){1.f, 1.f, 1.f, 1.f}; gv[1] = gv[0];
        if (do_norm) { gv[0] = *(const f32x4*)(gvec + colw); gv[1] = *(const f32x4*)(gvec + colw + 4); }
#pragma unroll
        for (int ai = 0; ai < 2; ++ai)
#pragma unroll
            for (int m = 0; m < 4; ++m) { const int rl = rl0 + ai * HALF + m * 16, row = u.pm * BM + rl, sp = row - b * SEQ; const float rs = rsv[ai][m];
                f32x4 c0 = (f32x4){1.f, 1.f, 1.f, 1.f}, c1 = c0, s0 = (f32x4){0.f, 0.f, 0.f, 0.f}, s1 = s0;
                if (do_norm && wc == 0) { const float fp = (float)sp; const int kb = 8 * (fq & 1);
#pragma unroll
                    for (int e = 0; e < 4; ++e) { float ca, sa, cb, sb; rope_cs(fp, kb + e, ROPE_L2T / 16.0f, ca, sa); rope_cs(fp, kb + 4 + e, ROPE_L2T / 16.0f, cb, sb); c0[e] = ca; s0[e] = sa; c1[e] = cb; s1[e] = sb; } }
#pragma unroll
                for (int bj = 0; bj < 2; ++bj) {
                    float rn = 1.0f;
                    if (do_norm) { const f32x4 t4 = *(const LAS f32x4*)(X + (bj * 256 + rl) * 4); rn = __builtin_amdgcn_rsqf(((t4[0] + t4[1]) + (t4[2] + t4[3])) * (1.0f / 128.0f) + EPS); }
                    f32x4 y0 = acc[ai][bj][m][0] * (rs * rn) * gv[0], y1 = acc[ai][bj][m][1] * (rs * rn) * gv[1];
                    if (do_norm && wc == 0) {
                        f32x4 p0, p1;
#pragma unroll
                        for (int e = 0; e < 4; ++e) { p0[e] = shx(y0[e], 32); p1[e] = shx(y1[e], 32); }
                        if (fq < 2) { y0 = y0 * c0 - p0 * s0; y1 = y1 * c1 - p1 * s1; } else { y0 = y0 * c0 + p0 * s0; y1 = y1 * c1 + p1 * s1; }
                    }
                    u32x4 w; w.x = cvt_pk_bf16(y0[0], y0[1]); w.y = cvt_pk_bf16(y0[2], y0[3]); w.z = cvt_pk_bf16(y1[0], y1[1]); w.w = cvt_pk_bf16(y1[2], y1[3]);
                    bf16* dst;
                    if (pn < 4) dst = Qn + (size_t)row * 1024 + (2 * pn + bj) * HD + colw;
                    else dst = (bf16*)(nsakv + (size_t)(pn - 4) * NSAKV_ONE) + ((size_t)(b * NG + bj) * SEQ + sp) * HD + colw;
                    *(u32x4*)dst = w; } asm volatile("" ::: "memory"); }
    }
};
struct EpiGateMix {
    static constexpr bool PERM = true, MID = true;
    bf16* O; const bf16* Z;
    __device__ __forceinline__ void mid(f32x4 (&acc)[2][2][4][2], const Unit& u, int wr, int wc, int fr, int fq) const {
        int row0 = u.pm * BM + wr * 64 + fr, col0 = u.pn * BM + wc * 32 + 8 * fq;
        asm volatile("" : "+v"(row0), "+v"(col0));
#pragma unroll
        for (int ai = 0; ai < 2; ++ai) {
            u32x4 zaw[4][2], zbw[4][2];
#pragma unroll
            for (int m = 0; m < 4; ++m)
#pragma unroll
                for (int bj = 0; bj < 2; ++bj) { const bf16* zp = Z + (size_t)(row0 + ai * HALF + m * 16) * DINP + ZM + col0 + bj * HALF; zaw[m][bj] = *(const u32x4*)zp; zbw[m][bj] = *(const u32x4*)(zp + DM); }
#pragma unroll
            for (int m = 0; m < 4; ++m)
#pragma unroll
                for (int bj = 0; bj < 2; ++bj) { float za[8], zb[8]; unpack8(zaw[m][bj], za); unpack8(zbw[m][bj], zb);
#pragma unroll
                    for (int e = 0; e < 4; ++e) {
                        acc[ai][bj][m][0][e] *= (1.0f + fexp2(-1.4426950408889634f * zb[e])) * frcp(1.0f + fexp2(-1.4426950408889634f * za[e]));
                        acc[ai][bj][m][1][e] *= (1.0f + fexp2(-1.4426950408889634f * zb[4 + e])) * frcp(1.0f + fexp2(-1.4426950408889634f * za[4 + e])); } }
            asm volatile("" ::: "memory"); }
    }
    __device__ __forceinline__ void operator()(const f32x4 (&acc)[2][2][4][2], const Unit& u, int wr, int wc, int fr, int fq) const {
        const int row0 = u.pm * BM + wr * 64 + fr, col0 = u.pn * BM + wc * 32 + 8 * fq;
#pragma unroll
        for (int ai = 0; ai < 2; ++ai) {
            u32x4 zw[4][2];
#pragma unroll
            for (int m = 0; m < 4; ++m)
#pragma unroll
                for (int bj = 0; bj < 2; ++bj) zw[m][bj] = *(const u32x4*)(Z + (size_t)(row0 + ai * HALF + m * 16) * DINP + ZM + DM + col0 + bj * HALF);
#pragma unroll
            for (int m = 0; m < 4; ++m)
#pragma unroll
                for (int bj = 0; bj < 2; ++bj) { float zf[8]; unpack8(zw[m][bj], zf);
                    const f32x4 v0 = acc[ai][bj][m][0], v1 = acc[ai][bj][m][1];
                    float o[8];
#pragma unroll
                    for (int e = 0; e < 4; ++e) { o[e] = sigmoidf_(zf[e]) * v0[e]; o[4 + e] = sigmoidf_(zf[4 + e]) * v1[e]; }
                    *(u32x4*)(O + (size_t)(row0 + ai * HALF + m * 16) * DM + col0 + bj * HALF) = pack8f(o); }
            asm volatile("" ::: "memory"); }
    }
};
template <bool RF32> struct EpiRes {
    static constexpr bool PERM = true, MID = false;
    bf16* O; const void* R; const float* gvec; bf16* hout; float* ss;
    __device__ __forceinline__ void operator()(const f32x4 (&acc)[2][2][4][2], const Unit& u, int wr, int wc, int fr, int fq) const {
        const int row0 = u.pm * BM + wr * 64 + fr, col0 = u.pn * BM + wc * 32 + 8 * fq;
        f32x4 gv[2][2];
        if (hout) {
#pragma unroll
            for (int bj = 0; bj < 2; ++bj)
#pragma unroll
                for (int n = 0; n < 2; ++n) gv[bj][n] = *(const f32x4*)(gvec + col0 + bj * HALF + 4 * n); }
#pragma unroll
        for (int ai = 0; ai < 2; ++ai) {
            f32x4 r[4][2][2];
#pragma unroll
            for (int m = 0; m < 4; ++m) { const size_t off = (size_t)(row0 + ai * HALF + m * 16) * DM + col0;
#pragma unroll
                for (int bj = 0; bj < 2; ++bj) {
                    if (RF32) { r[m][bj][0] = *(const f32x4*)((const float*)R + off + bj * HALF); r[m][bj][1] = *(const f32x4*)((const float*)R + off + bj * HALF + 4); }
                    else { const u32x4 w = *(const u32x4*)((const bf16*)R + off + bj * HALF); r[m][bj][0] = (f32x4){bflo(w.x), bfhi(w.x), bflo(w.y), bfhi(w.y)}; r[m][bj][1] = (f32x4){bflo(w.z), bfhi(w.z), bflo(w.w), bfhi(w.w)}; } } }
            asm volatile("" ::: "memory");
#pragma unroll
            for (int m = 0; m < 4; ++m) { const size_t off = (size_t)(row0 + ai * HALF + m * 16) * DM + col0; float sq = 0.f;
#pragma unroll
                for (int bj = 0; bj < 2; ++bj) { const f32x4 v0 = r[m][bj][0] + acc[ai][bj][m][0], v1 = r[m][bj][1] + acc[ai][bj][m][1];
                    u32x4 w; w.x = cvt_pk_bf16(v0[0], v0[1]); w.y = cvt_pk_bf16(v0[2], v0[3]); w.z = cvt_pk_bf16(v1[0], v1[1]); w.w = cvt_pk_bf16(v1[2], v1[3]);
                    *(u32x4*)(O + off + bj * HALF) = w;
                    if (hout) { const f32x4 h0 = v0 * gv[bj][0], h1 = v1 * gv[bj][1]; u32x4 hw; hw.x = cvt_pk_bf16(h0[0], h0[1]); hw.y = cvt_pk_bf16(h0[2], h0[3]); hw.z = cvt_pk_bf16(h1[0], h1[1]); hw.w = cvt_pk_bf16(h1[2], h1[3]);
                        *(u32x4*)(hout + off + bj * HALF) = hw;
                        sq += ((v0[0] * v0[0] + v0[1] * v0[1]) + (v0[2] * v0[2] + v0[3] * v0[3])) + ((v1[0] * v1[0] + v1[1] * v1[1]) + (v1[2] * v1[2] + v1[3] * v1[3])); } }
                if (hout) { sq = sum4x(sq); if (fq == 0) ss[(size_t)(row0 + ai * HALF + m * 16) * 32 + u.pn * 4 + wc] = sq; } }
            asm volatile("" ::: "memory");
        }
    }
};
template <bool F8> struct EpiSwigluT {
    static constexpr bool PERM = true, MID = false;
    void* O; const float* ss; float asc;
    __device__ __forceinline__ void operator()(const f32x4 (&acc)[2][2][4][2], const Unit& u, int wr, int wc, int fr, int fq) const {
        const int row0 = u.pm * BM + wr * 64 + fr, col0 = u.pn * HALF + wc * 32 + 8 * fq;
        float rsv[2][4]; row_rs8<32>(ss, row0, fq, rsv, 1.0f / DM);
#pragma unroll
        for (int ai = 0; ai < 2; ++ai)
#pragma unroll
            for (int m = 0; m < 4; ++m) { float o[8];
                const float rs = F8 ? rsv[ai][m] * asc : rsv[ai][m], rsb = F8 ? rs * F8_H_SCALE : rs;
#pragma unroll
                for (int n = 0; n < 2; ++n)
#pragma unroll
                    for (int e = 0; e < 4; ++e) { const float a = acc[ai][0][m][n][e] * rs, b = acc[ai][1][m][n][e] * rsb; o[4 * n + e] = a * sigmoidf_(a) * b; }
                if constexpr (F8) { u32x2 w; w.x = pk4_f8(o[0], o[1], o[2], o[3]); w.y = pk4_f8(o[4], o[5], o[6], o[7]); *(u32x2*)((unsigned char*)O + (size_t)(row0 + ai * HALF + m * 16) * DFF + col0) = w; }
                else *(u32x4*)((bf16*)O + (size_t)(row0 + ai * HALF + m * 16) * DFF + col0) = pack8f(o); }
    }
};
using EpiSwiglu = EpiSwigluT<false>;
struct EpiMoeDown {
    static constexpr bool PERM = true, MID = false;
    bf16* Y0; bf16* Yt; const float* slot_gate; int ks; float dsc;
    __device__ __forceinline__ void operator()(const f32x4 (&acc)[2][2][4][2], const Unit& u, int wr, int wc, int fr, int fq) const {
        int rl0 = wr * 64 + fr, cl0 = wc * 32 + 8 * fq; asm volatile("" : "+v"(rl0), "+v"(cl0));
        bf16* base; int ld;
        if (u.kidx == 0) { base = Y0 + (size_t)(u.pm * BM) * DM + u.pn * BM; ld = DM; } else { base = Yt + (size_t)(u.tail * (ks - 1) + u.kidx - 1) * 65536; ld = 256; }
#pragma unroll
        for (int ai = 0; ai < 2; ++ai)
#pragma unroll
            for (int m = 0; m < 4; ++m) { const int rl = rl0 + ai * HALF + m * 16; const float gt = slot_gate[u.pm * BM + rl] * dsc; bf16* op = base + (size_t)rl * ld + cl0;
#pragma unroll
                for (int bj = 0; bj < 2; ++bj) { const f32x4 v0 = acc[ai][bj][m][0] * gt, v1 = acc[ai][bj][m][1] * gt;
                    u32x4 w; w.x = cvt_pk_bf16(v0[0], v0[1]); w.y = cvt_pk_bf16(v0[2], v0[3]); w.z = cvt_pk_bf16(v1[0], v1[1]); w.w = cvt_pk_bf16(v1[2], v1[3]);
                    *(u32x4*)(op + bj * HALF) = w; } }
    }
};
template <class Epi, bool ALIGN_EPI = true, bool SP2 = true, int ES = 2>
__device__ __forceinline__ void gemm_phase(LAS unsigned char* lds, int wv, const Gemm g, const Order& S, const Epi& E) {
    int wid = wv; asm volatile("" : "+s"(wid));
    const int tid = fresh_tid(wid), lane = tid & 63, wr = wid >> 2, wc = wid & 3, fr = lane & 15, fq = lane >> 4;
    const int K = g.K;
    unsigned voffA[2], voffB[2];
#pragma unroll
    for (int i = 0; i < 2; ++i) { int R, C; stage_rc(tid * 16 + i * 8192, R, C); const int Rb = (Epi::PERM && ES == 2) ? ((R & ~31) + perm32(R & 31)) : R;
        voffA[i] = (unsigned)(R * g.lda * ES + C * 2); voffB[i] = (unsigned)(Rb * K * ES + C * 2); }
    const int kstep = BK * 2;
    const int hstepA = HALF * g.lda * ES, hstepB = HALF * K * ES;
    const unsigned ldsw = (unsigned)wid * 1024u;
    const int aoff = lds_byte(wr * 64 + fr, fq * 8), boff = lds_byte(wc * 32 + fr, fq * 8);
#define PG8_SA(b, h) (((b) * 2 + (h)) * HTB)
#define PG8_SB(b, h) ((4 + (b) * 2 + (h)) * HTB)
#define PG8_RS(p) __builtin_amdgcn_make_buffer_rsrc((void*)(p), 0, 0x7fffffff, 0x00020000)
#define PG8_STAGE(bufoff, gbase, soff, voff) do { _Pragma("unroll") for (int _i = 0; _i < 2; ++_i) \
        __builtin_amdgcn_raw_ptr_buffer_load_lds(PG8_RS(gbase), (LAS unsigned*)(lds + (bufoff) + ldsw + _i * 8192), 16, (int)(voff)[_i], (int)(soff), 0, 0); } while (0)
#define PG8_LD1(dst, adr) do { if constexpr (ES == 1) dst.v = __builtin_shufflevector(*(const LAS v4i_t*)(adr), *(const LAS v4i_t*)((adr) + 1024), 0, 1, 2, 3, 4, 5, 6, 7); \
        else { dst.k[0] = *(const LAS bf16x8*)(adr); dst.k[1] = *(const LAS bf16x8*)((adr) + 1024); } } while (0)
#define PG8_LDA(dst, b, h) do { _Pragma("unroll") for (int m = 0; m < 4; ++m) PG8_LD1(dst[m], lds + PG8_SA(b, h) + aoff + m * 2048); } while (0)
#define PG8_LDB(dst, b, h) do { _Pragma("unroll") for (int n = 0; n < 2; ++n) PG8_LD1(dst[n], lds + PG8_SB(b, h) + boff + n * 2048); } while (0)
#define PG8_MMA(ai, bj, At, Bt) do { __builtin_amdgcn_s_setprio(1); _Pragma("unroll") for (int m = 0; m < 4; ++m) _Pragma("unroll") for (int n = 0; n < 2; ++n) { \
        if constexpr (ES == 1) acc[ai][bj][m][n] = __builtin_amdgcn_mfma_scale_f32_16x16x128_f8f6f4(Bt[n].v, At[m].v, acc[ai][bj][m][n], 0, 0, 0, 0, 0, 0);     \
        else { _Pragma("unroll") for (int k = 0; k < 2; ++k) acc[ai][bj][m][n] = __builtin_amdgcn_mfma_f32_16x16x32_bf16(Bt[n].k[k], At[m].k[k], acc[ai][bj][m][n], 0, 0, 0); } } \
        __builtin_amdgcn_s_setprio(0); } while (0)
#define PG8_WAIT_V(n) asm volatile("s_waitcnt vmcnt(" #n ")" ::: "memory")
#define PG8_WAIT_L(n) asm volatile("s_waitcnt lgkmcnt(" #n ")" ::: "memory")
#define PG8_BAR __builtin_amdgcn_s_barrier()
#define PG8_SCHED __builtin_amdgcn_sched_barrier(0)
    Unit cur, nxt; int ui = 0;
    if (!S.next(0, cur)) return;
    f32x4 acc[2][2][4][2];
#pragma unroll
    for (int a = 0; a < 2; ++a)
#pragma unroll
        for (int b = 0; b < 2; ++b)
#pragma unroll
            for (int m = 0; m < 4; ++m)
#pragma unroll
                for (int n = 0; n < 2; ++n) acc[a][b][m][n] = (f32x4){0.f, 0.f, 0.f, 0.f};
    Frag<ES> At[4], B0[2], B1[2];
    const char* cA; const char* cB; S.ptrs(g, cur, cA, cB);
    if constexpr (SP2) {
        PG8_STAGE(PG8_SB(0, 0), cB, 0, voffB); PG8_STAGE(PG8_SB(0, 1), cB, hstepB, voffB); PG8_STAGE(PG8_SA(0, 0), cA, 0, voffA); PG8_STAGE(PG8_SA(0, 1), cA, hstepA, voffA);
        if (wr == 1) PG8_BAR;
        PG8_WAIT_V(2); PG8_BAR;
        PG8_STAGE(PG8_SB(1, 0), cB, kstep, voffB); PG8_STAGE(PG8_SA(1, 0), cA, kstep, voffA); PG8_STAGE(PG8_SB(1, 1), cB, hstepB + kstep, voffB);
        PG8_WAIT_V(6); PG8_BAR;
    } else {
        PG8_STAGE(PG8_SB(0, 0), cB, 0, voffB); PG8_STAGE(PG8_SA(0, 0), cA, 0, voffA); PG8_STAGE(PG8_SB(0, 1), cB, hstepB, voffB); PG8_STAGE(PG8_SA(0, 1), cA, hstepA, voffA);
        if (wr == 1) PG8_BAR;
        PG8_WAIT_V(4); PG8_BAR;
        PG8_STAGE(PG8_SB(1, 0), cB, kstep, voffB); PG8_STAGE(PG8_SA(1, 0), cA, kstep, voffA); PG8_STAGE(PG8_SB(1, 1), cB, hstepB + kstep, voffB);
        PG8_WAIT_V(6); PG8_BAR;
    }
    for (;;) {
        const bool has_next = S.next(ui + 1, nxt);
        const char* nA = cA; const char* nB = cB; if (has_next) S.ptrs(g, nxt, nA, nB);
        const int nt = cur.nt;
        for (int t = 0; t < nt; t += 2) {
            if constexpr (Epi::MID) { if (t == (nt >> 1)) { const int le = lane_id_fresh(); E.mid(acc, cur, wr, wc, le & 15, le >> 4); } }
            const bool last = (t == nt - 2);
            const int s1 = (t + 1) * kstep, s2 = last ? 0 : (t + 2) * kstep, s3 = s2 + kstep;
            const char* a2 = last ? nA : cA; const char* b2 = last ? nB : cB;
            if constexpr (SP2) {
            PG8_LDB(B0, 0, 0); PG8_LDB(B1, 0, 1); PG8_SCHED; PG8_LDA(At, 0, 0); PG8_STAGE(PG8_SA(1, 1), cA, s1 + hstepA, voffA);
            PG8_WAIT_V(8); PG8_WAIT_L(0); PG8_BAR; PG8_MMA(0, 0, At, B0); PG8_MMA(0, 1, At, B1); PG8_BAR; PG8_SCHED;
            PG8_LDA(At, 0, 1); PG8_STAGE(PG8_SB(0, 0), b2, s2, voffB); PG8_STAGE(PG8_SB(0, 1), b2, s2 + hstepB, voffB); PG8_STAGE(PG8_SA(0, 0), a2, s2, voffA);
            PG8_WAIT_V(8); PG8_WAIT_L(0); PG8_BAR; PG8_MMA(1, 0, At, B0); PG8_MMA(1, 1, At, B1); PG8_BAR; PG8_SCHED;
            PG8_LDB(B0, 1, 0); PG8_LDB(B1, 1, 1); PG8_SCHED; PG8_LDA(At, 1, 0); PG8_STAGE(PG8_SA(0, 1), a2, s2 + hstepA, voffA);
            PG8_WAIT_V(8); PG8_WAIT_L(0); PG8_BAR; PG8_MMA(0, 0, At, B0); PG8_MMA(0, 1, At, B1); PG8_BAR; PG8_SCHED;
            PG8_LDA(At, 1, 1); PG8_STAGE(PG8_SB(1, 0), b2, s3, voffB); PG8_STAGE(PG8_SB(1, 1), b2, s3 + hstepB, voffB); PG8_STAGE(PG8_SA(1, 0), a2, s3, voffA);
            PG8_WAIT_V(8); PG8_WAIT_L(0); PG8_BAR; PG8_MMA(1, 0, At, B0); PG8_MMA(1, 1, At, B1); PG8_BAR; PG8_SCHED;
            } else {
            PG8_LDB(B0, 0, 0); PG8_SCHED; PG8_LDA(At, 0, 0); PG8_STAGE(PG8_SA(1, 1), cA, s1 + hstepA, voffA);
            PG8_WAIT_L(8); PG8_BAR; PG8_WAIT_L(0); PG8_MMA(0, 0, At, B0); PG8_BAR; PG8_SCHED;
            PG8_LDB(B1, 0, 1); PG8_STAGE(PG8_SB(0, 0), b2, s2, voffB);
            PG8_BAR; PG8_WAIT_L(0); PG8_MMA(0, 1, At, B1); PG8_BAR;
            PG8_LDA(At, 0, 1); PG8_STAGE(PG8_SA(0, 0), a2, s2, voffA);
            PG8_BAR; PG8_WAIT_L(0); PG8_MMA(1, 0, At, B0); PG8_BAR; PG8_SCHED;
            PG8_STAGE(PG8_SB(0, 1), b2, s2 + hstepB, voffB);
            PG8_WAIT_V(6); PG8_BAR; PG8_MMA(1, 1, At, B1); PG8_BAR;
            PG8_LDB(B0, 1, 0); PG8_SCHED; PG8_LDA(At, 1, 0); PG8_STAGE(PG8_SA(0, 1), a2, s2 + hstepA, voffA);
            PG8_WAIT_L(8); PG8_BAR; PG8_WAIT_L(0); PG8_MMA(0, 0, At, B0); PG8_BAR; PG8_SCHED;
            PG8_LDB(B1, 1, 1); PG8_STAGE(PG8_SB(1, 0), b2, s3, voffB);
            PG8_BAR; PG8_WAIT_L(0); PG8_MMA(0, 1, At, B1); PG8_BAR;
            PG8_LDA(At, 1, 1); PG8_STAGE(PG8_SA(1, 0), a2, s3, voffA);
            PG8_BAR; PG8_WAIT_L(0); PG8_MMA(1, 0, At, B0); PG8_BAR; PG8_SCHED;
            PG8_STAGE(PG8_SB(1, 1), b2, s3 + hstepB, voffB);
            PG8_WAIT_V(6); PG8_BAR; PG8_MMA(1, 1, At, B1); PG8_BAR;
            }
        }
        if constexpr (ALIGN_EPI) { if (wr == 0) PG8_BAR; }
        { const int le = lane_id_fresh(); E(acc, cur, wr, wc, le & 15, le >> 4); }
        if (!has_next) break;
#pragma unroll
        for (int a = 0; a < 2; ++a)
#pragma unroll
            for (int b = 0; b < 2; ++b)
#pragma unroll
                for (int m = 0; m < 4; ++m)
#pragma unroll
                    for (int n = 0; n < 2; ++n) acc[a][b][m][n] = (f32x4){0.f, 0.f, 0.f, 0.f};
        cur = nxt; cA = nA; cB = nB; ++ui;
        if constexpr (ALIGN_EPI) { if (wr == 1) PG8_BAR; }
    }
    PG8_WAIT_V(0);
    if constexpr (!ALIGN_EPI) { if (wr == 0) PG8_BAR; }
    PG8_BAR;
#undef PG8_SA
#undef PG8_SB
#undef PG8_STAGE
#undef PG8_RS
#undef PG8_LDA
#undef PG8_LDB
#undef PG8_MMA
#undef PG8_LD1
#undef PG8_WAIT_V
#undef PG8_WAIT_L
#undef PG8_BAR
#undef PG8_SCHED
}
}

#define XB_TMO      128
#define XB_XCNT(j)  (256  + 64 * (j))
#define XB_XSUB(j)  (1280 + 64 * (j))
#define XB_XGEN(j)  (2304 + 64 * (j))
#define XB_TOP      3328
#define XB_TOPGEN   3392
#define XCD_BAR_WORDS 3456
#define XB_SPIN_CAP (1u << 18)
__device__ __forceinline__ unsigned xb_ld(unsigned* p)              { return __hip_atomic_load(p, __ATOMIC_RELAXED, __HIP_MEMORY_SCOPE_AGENT); }
__device__ __forceinline__ unsigned xb_add(unsigned* p, unsigned v) { return __hip_atomic_fetch_add(p, v, __ATOMIC_RELAXED, __HIP_MEMORY_SCOPE_AGENT); }
__device__ __forceinline__ unsigned xb_xcc_id() { return (unsigned)__builtin_amdgcn_s_getreg((3 << 11) | 20) & 0xFu; }
#define XB_SPIN(cond, bar) do { unsigned _sp = 0; while (cond) { __builtin_amdgcn_s_sleep(1); \
    if ((++_sp & 255u) == 0u) { if (xb_ld(&(bar)[XB_TMO])) break; if (_sp > XB_SPIN_CAP) { atomicAdd(&(bar)[XB_TMO], 1u); break; } } } } while (0)
struct XcdBarrier { unsigned* bar; unsigned x; volatile LAS unsigned* st; };
__device__ __forceinline__ XcdBarrier xcd_barrier_post(unsigned* bar, volatile LAS unsigned* st, int wv) {
    XcdBarrier b; b.bar = bar; b.x = (unsigned)wv; b.st = st;
    if (fresh_tid(wv) == 0) (void)xb_add(&bar[XB_XCNT(xb_xcc_id())], 1u);
    return b;
}
__device__ __forceinline__ void xcd_barrier_complete(unsigned* bar, unsigned x, unsigned& nloc, unsigned& nx) {
    const unsigned G = gridDim.x * gridDim.y * gridDim.z;
    unsigned sum, cnt, mine, sp = 0u;
    for (;;) {
        sum = 0u; cnt = 0u; mine = 0u;
#pragma unroll
        for (unsigned j = 0; j < 16; ++j) { const unsigned c = xb_ld(&bar[XB_XCNT(j)]); sum += c; cnt += (c > 0u) ? 1u : 0u; mine = (j == x) ? c : mine; }
        if (sum == G) break;
        __builtin_amdgcn_s_sleep(1);
        if ((++sp & 255u) == 0u) { if (xb_ld(&bar[XB_TMO])) break; if (sp > XB_SPIN_CAP) { atomicAdd(&bar[XB_TMO], 1u); break; } }
    }
    nloc = mine > 0u ? mine : 1u; nx = cnt > 0u ? cnt : 1u;
}
__device__ __forceinline__ void xcd_barrier(const XcdBarrier& b) {
    asm volatile("s_waitcnt vmcnt(0)" ::: "memory");
    __syncthreads();
    if (fresh_tid((int)b.x) == 0) {
        unsigned* bar = b.bar; const unsigned bx_ = xb_xcc_id();
        __builtin_amdgcn_s_waitcnt(0);
        unsigned nloc = b.st[0], nx = b.st[1];
        if (nloc == 0u) { xcd_barrier_complete(bar, bx_, nloc, nx); b.st[0] = nloc; b.st[1] = nx; }
        const unsigned old = xb_add(&bar[XB_XSUB(bx_)], 1u);
        const unsigned gen = old / nloc;
        if (old + 1u == (gen + 1u) * nloc) {
            __builtin_amdgcn_fence(__ATOMIC_RELEASE, "agent");
            asm volatile("s_waitcnt vmcnt(0)" ::: "memory");
            const unsigned og = xb_add(&bar[XB_TOP], 1u);
            const unsigned tg = og / nx;
            if (og + 1u == (tg + 1u) * nx) xb_add(&bar[XB_TOPGEN], 1u);
            else XB_SPIN(xb_ld(&bar[XB_TOPGEN]) == tg, bar);
            __builtin_amdgcn_fence(__ATOMIC_ACQUIRE, "agent");
            xb_add(&bar[XB_XGEN(bx_)], 1u);
            asm volatile("s_waitcnt vmcnt(0)" ::: "memory");
        } else {
            XB_SPIN(xb_ld(&bar[XB_XGEN(bx_)]) == gen, bar);
            __builtin_amdgcn_fence(__ATOMIC_ACQUIRE, "agent");
            asm volatile("s_waitcnt vmcnt(0)" ::: "memory");
        }
    }
    __syncthreads();
}

struct MatDesc { const float* src; bf16* dst; const float* gain; int K, N, mode, item0, ldd, pad; };
constexpr int NMAT = 43;
struct Args {
    const float* in[28]; float* out; unsigned char* ws;
    MatDesc mat[NMAT];
    int total_items, ph_lo, ph_hi, bg_item0;
    int nch0, nch_total, pad0, pad1;
};

#define GAS __attribute__((address_space(1)))
struct Ctx {
    LAS unsigned char* lds; unsigned* ctl; GAS unsigned char* ws;
    int vcu, G, wv;
};
struct Lane { int tid, lane, wave, gw, NGW; };
__device__ __forceinline__ Lane mk_lane(const Ctx& c) { Lane L; int w = c.wv; asm volatile("" : "+s"(w)); L.tid = fresh_tid(w); L.lane = L.tid & 63; L.wave = w; L.gw = c.vcu * 8 + L.wave; L.NGW = c.G * 8; return L; }

__device__ __forceinline__ int perm64(int r) { return (r & 15) + 16 * ((r >> 5) & 1) + 32 * ((r >> 4) & 1); }
__device__ __forceinline__ int win_dst_row(int n) {
    if (n < 2560) return n;
    if (n < 2584) return ZG + (n - 2560);
    if (n < 3352) return ZQA + (n - 2584);
    if (n < 3864) return ZKVA + (n - 3352);
    if (n < 3928) return ZKR + perm64(n - 3864);
    return ZM + (n - 3928);
}
__device__ __forceinline__ void conv_load(const MatDesc& d, int item, int lane, f32x4 (&v)[8], int& n, int& k0) {
    const int N = d.N, nblk = (N + 31) >> 5, kb = item / nblk, nb = item - kb * nblk;
    k0 = 64 * kb + 8 * (lane & 7); n = 32 * nb + 4 * (lane >> 3);
    if (n < N) {
#pragma unroll
        for (int r = 0; r < 8; ++r) v[r] = __builtin_nontemporal_load((const f32x4*)(d.src + (size_t)(k0 + r) * N + n)); }
}
__device__ __forceinline__ void conv_store(const MatDesc& d, int lane, f32x4 (&v)[8], int n, int k0) {
    if (n < d.N) {
        if (d.gain) { const f32x4 g0 = *(const f32x4*)(d.gain + k0), g1 = *(const f32x4*)(d.gain + k0 + 4);
#pragma unroll
            for (int r = 0; r < 4; ++r) { v[r] = v[r] * g0[r]; v[4 + r] = v[4 + r] * g1[r]; } }
        int drow;
        if (d.mode == 0) drow = n; else if (d.mode == 1) drow = win_dst_row(n); else if (d.mode == 4) { const int hq = n / 192, dq = n - hq * 192; drow = dq < 128 ? hq * 128 + dq : 1024 + hq * 64 + perm64(dq - 128); }
        else drow = 256 * (n >> 7) + (n & 127) + (d.mode == 3 ? 128 : 0);
        if (d.pad) { const float qs = __builtin_ldexpf(1.0f, d.pad);
            { const int q = drow & 31; drow = (drow & ~31) + 16 * ((q >> 2) & 1) + 4 * (q >> 3) + (q & 3); }
#pragma unroll
            for (int e = 0; e < 4; ++e) {
                u32x2 w; w.x = pk4_f8(v[0][e] * qs, v[1][e] * qs, v[2][e] * qs, v[3][e] * qs); w.y = pk4_f8(v[4][e] * qs, v[5][e] * qs, v[6][e] * qs, v[7][e] * qs);
                *(u32x2*)((unsigned char*)d.dst + (size_t)(drow + e) * d.ldd + k0) = w; } }
        else {
#pragma unroll
        for (int e = 0; e < 4; ++e) {
            u32x4 w; w.x = cvt_pk_bf16(v[0][e], v[1][e]); w.y = cvt_pk_bf16(v[2][e], v[3][e]); w.z = cvt_pk_bf16(v[4][e], v[5][e]); w.w = cvt_pk_bf16(v[6][e], v[7][e]);
            *(u32x4*)(d.dst + (size_t)(drow + e) * d.ldd + k0) = w; } } }
}
__device__ __forceinline__ void conv_chunk(const Args& a, const Ctx& c, int chunk) {
    const Lane L = mk_lane(c);
    const int base = a.bg_item0 + chunk * 128;
    int mi = 5;
    for (int i = 0; i < 16; i += 2) {
        const int it0 = base + L.wave + 8 * i, it1 = it0 + 8;
        if (it0 >= a.total_items) break;
        while (mi + 1 < NMAT && it0 >= a.mat[mi + 1].item0) ++mi;
        int mj = mi; while (mj + 1 < NMAT && it1 >= a.mat[mj + 1].item0) ++mj;
        f32x4 v0[8], v1[8]; int n0, k00, n1 = 0, k01 = 0; const bool two = it1 < a.total_items;
        conv_load(a.mat[mi], it0 - a.mat[mi].item0, L.lane, v0, n0, k00);
        if (two) conv_load(a.mat[mj], it1 - a.mat[mj].item0, L.lane, v1, n1, k01);
        conv_store(a.mat[mi], L.lane, v0, n0, k00);
        if (two) conv_store(a.mat[mj], L.lane, v1, n1, k01);
    }
}
__device__ __forceinline__ int attn_item_cost(int id) {
    const int kind = id >> 8, idx = id & 255;
    if (kind == 0) return 160 * ((idx >> 4) + 1);
    const int chunk = idx >> 2;
    if (kind == 1) return 32 * (chunk + 1) + 8;
    return 32 * (chunk + 1 < 9 ? chunk + 1 : 9) + 8;
}
__device__ __forceinline__ void p0_prologue(const Args& a, const Ctx& c) {
    const Lane L = mk_lane(c);
    { int mi = 0;
      for (int it = L.gw; it < a.bg_item0; it += L.NGW) {
          while (mi + 1 < NMAT && it >= a.mat[mi + 1].item0) ++mi;
          { f32x4 v[8]; int n = 0, k0 = 0; conv_load(a.mat[mi], it - a.mat[mi].item0, L.lane, v, n, k0); conv_store(a.mat[mi], L.lane, v, n, k0); }
      } }
    for (int l = 0; l < 2; ++l) { u32x4* p = (u32x4*)(c.ws + WS_WL + l * WL_STRIDE + WL_IN + (size_t)3928 * DM * 2); const int n16 = 168 * DM * 2 / 16;
        for (int i = L.gw * 64 + L.lane; i < n16; i += L.NGW * 64) p[i] = (u32x4){0u, 0u, 0u, 0u}; }
    { float* tab = (float*)(c.ws + WS_TAB); const int gt = L.gw * 64 + L.lane, NT = L.NGW * 64;
      const double LT = 13.122363377404328;
      for (int i = gt; i < SEQ * 16; i += NT) { const int pos = i >> 4, k = i & 15; const float inv = (float)exp(-LT * (double)k / 16.0); const float ang = (float)pos * inv;
          const double rev = (double)ang * 0.15915494309189535; const float fr = (float)(rev - floor(rev));
          tab[TAB_COS_TOK / 4 + i] = __builtin_amdgcn_cosf(fr); tab[TAB_SIN_TOK / 4 + i] = __builtin_amdgcn_sinf(fr); }
      for (int i = gt; i < SEQ * 32; i += NT) { const int pos = i >> 5, k = i & 31; const float inv = (float)exp(-LT * (double)k / 32.0); const float ang = (float)pos * inv;
          const double rev = (double)ang * 0.15915494309189535; const float fr = (float)(rev - floor(rev));
          tab[TAB_COS_MLA / 4 + i] = __builtin_amdgcn_cosf(fr); tab[TAB_SIN_MLA / 4 + i] = __builtin_amdgcn_sinf(fr); }
      for (int i = gt; i < 256 * 16; i += NT) { const int n = i >> 4, k = i & 15; const int pos = 16 * n + 31; const float inv = (float)exp(-LT * (double)k / 16.0); const float ang = (float)pos * inv;
          const double rev = (double)ang * 0.15915494309189535; const float fr = (float)(rev - floor(rev));
          tab[TAB_COS_CMP / 4 + i] = __builtin_amdgcn_cosf(fr); tab[TAB_SIN_CMP / 4 + i] = __builtin_amdgcn_sinf(fr); }
      int* order = (int*)(c.ws + WS_TAB + TAB_ORDER);
      for (int i = gt; i < 512; i += NT) { const int ci = attn_item_cost(i); int rank = 0;
          for (int j = 0; j < 512; ++j) { const int cj = attn_item_cost(j); rank += (cj > ci || (cj == ci && j < i)) ? 1 : 0; }
          order[rank] = i; }
    }
}

template <bool ROUTER, bool XBF16 = false> __device__ __forceinline__ void norm_phase(const Ctx& c, const void* xv, const float* g, bf16* h, const float* wr, float* route) {
    const Lane L = mk_lane(c);
    const f32x4* g4 = (const f32x4*)g;
    for (int row = L.gw; row < T; row += L.NGW) {
        f32x4 v[8]; float ss = 0.f;
#pragma unroll
        for (int j = 0; j < 8; ++j) {
            if (XBF16) { const u32x2 w = ((const u32x2*)((const bf16*)xv + (size_t)row * DM))[L.lane + 64 * j]; v[j] = (f32x4){bflo(w.x), bfhi(w.x), bflo(w.y), bfhi(w.y)}; }
            else v[j] = ((const f32x4*)((const float*)xv + (size_t)row * DM))[L.lane + 64 * j];
            ss += (v[j][0] * v[j][0] + v[j][1] * v[j][1]) + (v[j][2] * v[j][2] + v[j][3] * v[j][3]); }
        const float r = 1.0f / sqrtf(wave_sum(ss) * (1.0f / DM) + EPS);
        u32x2* o = (u32x2*)(h + (size_t)row * DM) + L.lane;
        float lg[8];
        if (ROUTER) {
#pragma unroll
            for (int e = 0; e < 8; ++e) lg[e] = 0.f; }
#pragma unroll
        for (int j = 0; j < 8; ++j) { const f32x4 gg = g4[L.lane + 64 * j]; v[j] = v[j] * r * gg;
            u32x2 w; w.x = cvt_pk_bf16(v[j][0], v[j][1]); w.y = cvt_pk_bf16(v[j][2], v[j][3]); o[64 * j] = w;
            if (ROUTER) { const f32x4* wp = (const f32x4*)(wr + (size_t)(4 * (L.lane + 64 * j)) * 8);
#pragma unroll
                for (int q = 0; q < 4; ++q) { const f32x4 w0 = wp[2 * q], w1 = wp[2 * q + 1]; const float y = v[j][q];
                    lg[0] += y * w0[0]; lg[1] += y * w0[1]; lg[2] += y * w0[2]; lg[3] += y * w0[3]; lg[4] += y * w1[0]; lg[5] += y * w1[1]; lg[6] += y * w1[2]; lg[7] += y * w1[3]; } } }
        if (ROUTER) {
#pragma unroll
            for (int e = 0; e < 8; ++e) lg[e] = wave_sum(lg[e]);
            int i0 = 0; float m0 = lg[0];
#pragma unroll
            for (int e = 1; e < 8; ++e) if (lg[e] > m0) { m0 = lg[e]; i0 = e; }
            int i1 = -1; float m1 = -3.0e38f;
#pragma unroll
            for (int e = 0; e < 8; ++e) if (e != i0 && lg[e] > m1) { m1 = lg[e]; i1 = e; }
            const float ex = __expf(m1 - m0), g0 = 1.0f / (1.0f + ex), g1 = ex / (1.0f + ex);
            if (L.lane == 0) { f32x4 o4; o4[0] = __int_as_float(i0); o4[1] = __int_as_float(i1); o4[2] = g0; o4[3] = g1; *(f32x4*)(route + (size_t)row * 4) = o4; }
        }
    }
}

__device__ __forceinline__ void load16(const bf16* p, float (&v)[16]) { const u32x4 a = *(const u32x4*)p, b = *(const u32x4*)(p + 8); float t0[8], t1[8]; unpack8(a, t0); unpack8(b, t1);
#pragma unroll
    for (int i = 0; i < 8; ++i) { v[i] = t0[i]; v[8 + i] = t1[i]; } }
__device__ __forceinline__ void store16(bf16* p, const float (&v)[16]) { *(u32x4*)p = pack8f(v); *(u32x4*)(p + 8) = pack8f(v + 8); }
__device__ __forceinline__ void chunk_norm_rope(float (&v)[16], int sub, bool do_norm, const float* gvec, bool do_rope, const float* cs, const float* sn) {
    float ss = 0.f;
#pragma unroll
    for (int i = 0; i < 16; ++i) ss += v[i] * v[i];
    ss += shx(ss, 1); ss += shx(ss, 2); ss += shx(ss, 4);
    const float r = do_norm ? 1.0f / sqrtf(ss * (1.0f / 128.0f) + EPS) : 1.0f;
#pragma unroll
    for (int i = 0; i < 16; ++i) { const float gg = do_norm ? gvec[sub * 16 + i] : 1.0f; v[i] = v[i] * r * gg; }
#pragma unroll
    for (int i = 0; i < 16; ++i) { const float pv = shx(v[i], 1); const float cc = cs[i], s2 = sn[i];
        const float o = (sub == 0) ? v[i] * cc - pv * s2 : v[i] * cc + pv * s2; if (do_rope && sub < 2) v[i] = o; }
}
__device__ __forceinline__ void postz_phase(const Ctx& c, const Args& a, int l) {
    const Lane L = mk_lane(c);
    const bf16* z = (const bf16*)(c.ws + WS_Z);
    const float* tab = (const float*)(c.ws + WS_TAB);
    const float* qg = a.in[3] + l * 128; const float* kg = a.in[4] + l * 384;
    const float* qag = a.in[9] + l * QLORA; const float* kvag = a.in[11] + l * KVLORA; const float* krg = a.in[16] + l * 64;
    bf16* Qn = (bf16*)(c.ws + WS_QN); bf16* qan = (bf16*)(c.ws + WS_QAN); bf16* kvan = (bf16*)(c.ws + WS_KVAN); bf16* Kr = (bf16*)(c.ws + WS_KR); float* gn = (float*)(c.ws + WS_GNSA);
    const int lane = L.lane, sub = lane & 7, ch = lane >> 3;
    for (int row = L.gw; row < T; row += L.NGW) {
        const bf16* zr = z + (size_t)row * DINP; const int b = row / SEQ, s = row % SEQ;
        const float* cs = tab + TAB_COS_TOK / 4 + s * 16; const float* sn = tab + TAB_SIN_TOK / 4 + s * 16;
        float v[16];
        load16(zr + ZQ + lane * 16, v); chunk_norm_rope(v, sub, true, qg, true, cs, sn); store16(Qn + (size_t)row * 1024 + lane * 16, v);
#pragma unroll
        for (int pass = 0; pass < 2; ++pass) {
            const int chunk = pass == 0 ? ch : 8 + (ch & 3); const int br = chunk >> 2, kv = (chunk >> 1) & 1, g = chunk & 1;
            load16(zr + ZKV + chunk * 128 + sub * 16, v);
            const bool nr = (kv == 0) && (br >= 1);
            chunk_norm_rope(v, sub, nr, kg + br * 128, nr, cs, sn);
            bf16* dst = (bf16*)(c.ws + WS_NSAKV + (size_t)(br * 2 + kv) * NSAKV_ONE) + ((size_t)(b * NG + g) * SEQ + s) * HD + sub * 16;
            if (pass == 0 || lane < 32) store16(dst, v);
        }
        { const u32x2* p = (const u32x2*)(zr + ZQA + lane * 12); float f[12]; float ss = 0.f;
#pragma unroll
          for (int j = 0; j < 3; ++j) { const u32x2 w = p[j]; f[4 * j] = bflo(w.x); f[4 * j + 1] = bfhi(w.x); f[4 * j + 2] = bflo(w.y); f[4 * j + 3] = bfhi(w.y); }
#pragma unroll
          for (int j = 0; j < 12; ++j) ss += f[j] * f[j];
          const float r = 1.0f / sqrtf(wave_sum(ss) * (1.0f / QLORA) + EPS);
          u32x2* o = (u32x2*)(qan + (size_t)row * QLORA + lane * 12);
#pragma unroll
          for (int j = 0; j < 3; ++j) { u32x2 w; w.x = cvt_pk_bf16(f[4 * j] * r * qag[lane * 12 + 4 * j], f[4 * j + 1] * r * qag[lane * 12 + 4 * j + 1]);
              w.y = cvt_pk_bf16(f[4 * j + 2] * r * qag[lane * 12 + 4 * j + 2], f[4 * j + 3] * r * qag[lane * 12 + 4 * j + 3]); o[j] = w; } }
        { const u32x4 w = *(const u32x4*)(zr + ZKVA + lane * 8); float f[8]; unpack8(w, f); float ss = 0.f;
#pragma unroll
          for (int j = 0; j < 8; ++j) ss += f[j] * f[j];
          const float r = 1.0f / sqrtf(wave_sum(ss) * (1.0f / KVLORA) + EPS);
#pragma unroll
          for (int j = 0; j < 8; ++j) f[j] = f[j] * r * kvag[lane * 8 + j];
          *(u32x4*)(kvan + (size_t)row * KVLORA + lane * 8) = pack8f(f); }
        { const float f = bf2f(zr[ZKR + lane]); const float r = 1.0f / sqrtf(wave_sum(f * f) * (1.0f / 64.0f) + EPS); const float y = f * r * krg[lane];
          const float pv = shx(y, 32); const int i = lane & 31; const float cc = tab[TAB_COS_MLA / 4 + s * 32 + i], s2 = tab[TAB_SIN_MLA / 4 + s * 32 + i];
          const float o = lane < 32 ? y * cc - pv * s2 : y * cc + pv * s2;
          Kr[(size_t)row * 64 + lane] = (bf16)(cvt_pk_bf16(o, 0.f) & 0xffffu); }
        if (lane < 24) gn[(size_t)row * 24 + lane] = sigmoidf_(bf2f(zr[ZG + lane]));
    }
}

__device__ __forceinline__ void postmla_phase(const Ctx& c, const Args& a, int l) {
    const Lane L = mk_lane(c);
    const bf16* Qraw = (const bf16*)(c.ws + WS_QRAW); const bf16* KVraw = (const bf16*)(c.ws + WS_KVRAW);
    bf16* Qm = (bf16*)(c.ws + WS_QM); bf16* Km = (bf16*)(c.ws + WS_KM);
    const float* tab = (const float*)(c.ws + WS_TAB);
    const float* mqg = a.in[13] + l * 128; const float* mqrg = a.in[14] + l * 64; const float* mkg = a.in[15] + l * 128;
    const int lane = L.lane, sub = lane & 7, hh = lane >> 3;
    const bf16* z = (const bf16*)(c.ws + WS_Z); const float* krg = a.in[16] + l * 64; bf16* Kr = (bf16*)(c.ws + WS_KR); float* gn = (float*)(c.ws + WS_GNSA);
    for (int row = L.gw; row < T; row += L.NGW) {
        const int s = row % SEQ; float v[16];
        { const bf16* zr = z + (size_t)row * DINP;
          const float f = bf2f(zr[ZKR + lane]); const float r = 1.0f / sqrtf(wave_sum(f * f) * (1.0f / 64.0f) + EPS); const float y = f * r * krg[lane];
          const float pv = shx(y, 32); const int i = lane & 31; const float cc = tab[TAB_COS_MLA / 4 + s * 32 + i], s2 = tab[TAB_SIN_MLA / 4 + s * 32 + i];
          const float o = lane < 32 ? y * cc - pv * s2 : y * cc + pv * s2;
          Kr[(size_t)row * 64 + lane] = (bf16)(cvt_pk_bf16(o, 0.f) & 0xffffu);
          if (lane < 24) gn[(size_t)row * 24 + lane] = sigmoidf_(bf2f(zr[ZG + lane])); }
        load16(Qraw + (size_t)row * 1536 + hh * 192 + sub * 16, v); chunk_norm_rope(v, sub, true, mqg, false, tab, tab); store16(Qm + ((size_t)row * 8 + hh) * 192 + sub * 16, v);
        { const int bb = row / SEQ; const size_t hm = (((size_t)bb * 8 + hh) * SEQ + s) * 128 + sub * 16;
          load16(KVraw + (size_t)row * 2048 + hh * 256 + sub * 16, v); chunk_norm_rope(v, sub, true, mkg, false, tab, tab); store16(Km + hm, v);
          const u32x4 v0 = *(const u32x4*)(KVraw + (size_t)row * 2048 + hh * 256 + 128 + sub * 16), v1 = *(const u32x4*)(KVraw + (size_t)row * 2048 + hh * 256 + 128 + sub * 16 + 8);
          bf16* Vm = (bf16*)(c.ws + WS_VM); *(u32x4*)(Vm + hm) = v0; *(u32x4*)(Vm + hm + 8) = v1; }
        { const u32x4 w = *(const u32x4*)(Qraw + (size_t)row * 1536 + hh * 192 + 128 + sub * 8); float f[8]; unpack8(w, f); float ss = 0.f;
#pragma unroll
          for (int j = 0; j < 8; ++j) ss += f[j] * f[j];
          ss += shx(ss, 1); ss += shx(ss, 2); ss += shx(ss, 4);
          const float r = 1.0f / sqrtf(ss * (1.0f / 64.0f) + EPS);
#pragma unroll
          for (int j = 0; j < 8; ++j) f[j] = f[j] * r * mqrg[sub * 8 + j];
          float o[8];
#pragma unroll
          for (int j = 0; j < 8; ++j) { const float pv = shx(f[j], 4); const int i = 8 * (sub & 3) + j; const float cc = tab[TAB_COS_MLA / 4 + s * 32 + i], s2 = tab[TAB_SIN_MLA / 4 + s * 32 + i];
              o[j] = sub < 4 ? f[j] * cc - pv * s2 : f[j] * cc + pv * s2; }
          *(u32x4*)(Qm + ((size_t)row * 8 + hh) * 192 + 128 + sub * 8) = pack8f(o); }
    }
}

__device__ __forceinline__ void compress_phase(const Ctx& c, const Args& a, int l, int u0, int ustep) {
    const Lane L = mk_lane(c);
    const float* tab = (const float*)(c.ws + WS_TAB);
    const float* kg0 = a.in[4] + l * 384;
    LAS float* P = (LAS float*)c.lds;
    const int lane = L.lane, w = L.wave, r = lane & 31, h = lane >> 5;
    for (int u = u0; u < 64; u += ustep) {
        const int nblk = u & 7, kv = (u >> 3) & 1, g = (u >> 4) & 1, b = u >> 5;
        const bf16* src = (const bf16*)(c.ws + WS_NSAKV + (size_t)kv * NSAKV_ONE) + (size_t)(b * NG + g) * SEQ * HD;
        const float* pe = (kv == 0 ? a.in[5] : a.in[6]) + l * 32 * 128;
        const bf16* wt = (const bf16*)(c.ws + WS_WL + l * WL_STRIDE + (kv == 0 ? WL_CK : WL_CV)) + (size_t)r * 4096;
        const int n = 32 * nblk + r;
        f32x16 acc[4];
#pragma unroll
        for (int eb = 0; eb < 4; ++eb)
#pragma unroll
            for (int i = 0; i < 16; ++i) acc[eb][i] = 0.f;
#pragma unroll 4
        for (int s = 0; s < 32; ++s) {
            const int k = 512 * w + 16 * s + 8 * h, lt = k >> 7, d = k & 127; int tok = 16 * n + lt; tok = tok < SEQ ? tok : SEQ - 1;
            const u32x4 xw = *(const u32x4*)(src + (size_t)tok * HD + d); float xf[8]; unpack8(xw, xf);
            const f32x4 p0 = *(const f32x4*)(pe + lt * 128 + d), p1 = *(const f32x4*)(pe + lt * 128 + d + 4);
            u32x4 bw[4];
#pragma unroll
            for (int eb = 0; eb < 4; ++eb) bw[eb] = *(const u32x4*)(wt + (size_t)eb * 32 * 4096 + k);
#pragma unroll
            for (int i = 0; i < 4; ++i) { xf[i] += p0[i]; xf[4 + i] += p1[i]; }
            const u32x4 aw = pack8f(xf);
#pragma unroll
            for (int eb = 0; eb < 4; ++eb) acc[eb] = __builtin_amdgcn_mfma_f32_32x32x16_bf16(*(const bf16x8*)&aw, *(const bf16x8*)&bw[eb], acc[eb], 0, 0, 0);
        }
        __syncthreads();
#pragma unroll
        for (int eb = 0; eb < 4; ++eb)
#pragma unroll
            for (int i = 0; i < 16; ++i) P[(w * 32 + ((i & 3) + 8 * (i >> 2) + 4 * h)) * 128 + 32 * eb + r] = acc[eb][i];
        __syncthreads();
        { const int nl = L.tid >> 4, e0 = (L.tid & 15) * 8, ng = 32 * nblk + nl; float v[8];
#pragma unroll
          for (int i = 0; i < 8; ++i) v[i] = 0.f;
#pragma unroll
          for (int ww = 0; ww < 8; ++ww) { const f32x4 q0 = *(const LAS f32x4*)(P + (ww * 32 + nl) * 128 + e0), q1 = *(const LAS f32x4*)(P + (ww * 32 + nl) * 128 + e0 + 4);
#pragma unroll
              for (int i = 0; i < 4; ++i) { v[i] += q0[i]; v[4 + i] += q1[i]; } }
          if (kv == 0) {
              float ss = 0.f;
#pragma unroll
              for (int i = 0; i < 8; ++i) ss += v[i] * v[i];
              ss += shx(ss, 1); ss += shx(ss, 2); ss += shx(ss, 4); ss += shx(ss, 8);
              const float rr = 1.0f / sqrtf(ss * (1.0f / 128.0f) + EPS);
#pragma unroll
              for (int i = 0; i < 8; ++i) v[i] = v[i] * rr * kg0[e0 + i];
              const int q = L.tid & 15;
#pragma unroll
              for (int i = 0; i < 8; ++i) { const float pv = shx(v[i], 2); const int ci = (e0 & 15) + i; const float cc = tab[TAB_COS_CMP / 4 + ng * 16 + ci], s2 = tab[TAB_SIN_CMP / 4 + ng * 16 + ci];
                  const float o = q < 2 ? v[i] * cc - pv * s2 : v[i] * cc + pv * s2; if (q < 4) v[i] = o; }
          }
          if (ng >= 255) {
#pragma unroll
              for (int i = 0; i < 8; ++i) v[i] = 0.f; }
          bf16* dst = (bf16*)(c.ws + (kv == 0 ? WS_KC : WS_VC)) + ((size_t)(b * NG + g) * 256 + ng) * HD + e0;
          *(u32x4*)dst = pack8f(v); }
        __syncthreads();
    }
}

constexpr int AT_K = 0, AT_K2 = 32768, AT_V = 49152, AT_IMP = 81920, AT_CTL = 81920 + 16640;
__device__ __forceinline__ unsigned offb(unsigned row, unsigned ch) { return 256u * row + 16u * (ch ^ (((row & 3u) << 2) | ((row >> 2) & 3u))); }
__device__ __forceinline__ unsigned offr(unsigned row, unsigned ch) { return 128u * row + 16u * (ch ^ (row & 7u)); }

struct AttnSrc { const bf16* K; int ks; const bf16* K2; int k2s; const bf16* V; int vs; };

template <int MODE> struct AttnState {
    static constexpr int NQ = (MODE == 1) ? 12 : 8;
    bf16x8 qf[NQ]; unsigned ka[8]; unsigned k2a[4]; unsigned va[4][2];
};
template <int MODE> __device__ __forceinline__ void attn_setup(AttnState<MODE>& st, int lane, const bf16* qrow) {
    const unsigned r = lane & 31, h = lane >> 5;
#pragma unroll
    for (int s = 0; s < AttnState<MODE>::NQ; ++s) st.qf[s] = *(const bf16x8*)(qrow + 16 * s + 8 * h);
#pragma unroll
    for (int s = 0; s < 8; ++s) st.ka[s] = offb(r, 2 * s + h);
#pragma unroll
    for (int s = 0; s < 4; ++s) st.k2a[s] = offr(r, 2 * s + h);
    const unsigned blk = (lane >> 4) & 1, q = (lane & 15) >> 2, p = lane & 3;
#pragma unroll
    for (int cc = 0; cc < 4; ++cc)
#pragma unroll
        for (int tt = 0; tt < 2; ++tt) st.va[cc][tt] = offb(8 * tt + 4 * h + q, 4 * cc + 2 * blk + (p >> 1)) + 8 * (p & 1);
}
template <int MODE> __device__ __forceinline__ void attn_issue(const AttnSrc& S, int j, int tid, u32x4 (&kreg)[2], u32x4& k2reg, u32x4 (&vreg)[2], bool with_v) {
#pragma unroll
    for (int i = 0; i < 2; ++i) { const int id = tid + 512 * i, row = id >> 4, ch = id & 15;
        kreg[i] = *(const u32x4*)((const char*)S.K + (unsigned)(((64 * j + row) * S.ks + 8 * ch) * 2));
        if (with_v) vreg[i] = *(const u32x4*)((const char*)S.V + (unsigned)(((64 * j + row) * S.vs + 8 * ch) * 2)); }
    if (MODE == 1) { const int row = tid >> 3, ch = tid & 7; k2reg = *(const u32x4*)((const char*)S.K2 + (unsigned)(((64 * j + row) * S.k2s + 8 * ch) * 2)); }
}
template <int MODE> __device__ __forceinline__ void attn_write(LAS unsigned char* lds, int cur, int tid, const u32x4 (&kreg)[2], const u32x4& k2reg, const u32x4 (&vreg)[2], bool with_v) {
#pragma unroll
    for (int i = 0; i < 2; ++i) { const int id = tid + 512 * i, row = id >> 4, ch = id & 15;
        *(LAS u32x4*)(lds + AT_K + cur * 16384 + offb(row, ch)) = kreg[i];
        if (with_v) *(LAS u32x4*)(lds + AT_V + cur * 16384 + offb(row, ch)) = vreg[i]; }
    if (MODE == 1) { const int row = tid >> 3, ch = tid & 7; *(LAS u32x4*)(lds + AT_K2 + cur * 8192 + offr(row, ch)) = k2reg; }
}
template <int MODE> __device__ __forceinline__ void attn_scores(const AttnState<MODE>& st, LAS unsigned char* lds, int cur, int j, int lane, int t, u64 rowmask, unsigned W, bool full, bool rowonly, f32x16& p0, f32x16& p1) {
    const unsigned h = lane >> 5;
#pragma unroll
    for (int i = 0; i < 16; ++i) { p0[i] = 0.f; p1[i] = 0.f; }
    LAS unsigned char* kb = lds + AT_K + cur * 16384;
    if constexpr (MODE == 1) {
#pragma unroll
        for (int s = 0; s < 8; ++s) { const bf16x8 k0 = *(const LAS bf16x8*)(kb + st.ka[s]), k1 = *(const LAS bf16x8*)(kb + st.ka[s] + 8192);
            p0 = __builtin_amdgcn_mfma_f32_32x32x16_bf16(k0, st.qf[s], p0, 0, 0, 0); p1 = __builtin_amdgcn_mfma_f32_32x32x16_bf16(k1, st.qf[s], p1, 0, 0, 0); }
        LAS unsigned char* k2p = lds + AT_K2 + cur * 8192;
#pragma unroll
        for (int s = 0; s < 4; ++s) { const bf16x8 k0 = *(const LAS bf16x8*)(k2p + st.k2a[s]), k1 = *(const LAS bf16x8*)(k2p + st.k2a[s] + 4096);
            p0 = __builtin_amdgcn_mfma_f32_32x32x16_bf16(k0, st.qf[8 + s], p0, 0, 0, 0); p1 = __builtin_amdgcn_mfma_f32_32x32x16_bf16(k1, st.qf[8 + s], p1, 0, 0, 0); }
    } else {
    bf16x8 fa[4], fb[4];
#define AT_LDK(dst, s0) do { dst[0] = *(const LAS bf16x8*)(kb + st.ka[s0]); dst[1] = *(const LAS bf16x8*)(kb + st.ka[s0] + 8192); dst[2] = *(const LAS bf16x8*)(kb + st.ka[(s0) + 1]); dst[3] = *(const LAS bf16x8*)(kb + st.ka[(s0) + 1] + 8192); } while (0)
#define AT_MMK(src, s0) do { p0 = __builtin_amdgcn_mfma_f32_32x32x16_bf16(src[0], st.qf[s0], p0, 0, 0, 0); p1 = __builtin_amdgcn_mfma_f32_32x32x16_bf16(src[1], st.qf[s0], p1, 0, 0, 0); \
        p0 = __builtin_amdgcn_mfma_f32_32x32x16_bf16(src[2], st.qf[(s0) + 1], p0, 0, 0, 0); p1 = __builtin_amdgcn_mfma_f32_32x32x16_bf16(src[3], st.qf[(s0) + 1], p1, 0, 0, 0); } while (0)
    AT_LDK(fa, 0); __builtin_amdgcn_sched_barrier(0);
    AT_LDK(fb, 2); __builtin_amdgcn_sched_barrier(0); AT_MMK(fa, 0); __builtin_amdgcn_sched_barrier(0);
    AT_LDK(fa, 4); __builtin_amdgcn_sched_barrier(0); AT_MMK(fb, 2); __builtin_amdgcn_sched_barrier(0);
    AT_LDK(fb, 6); __builtin_amdgcn_sched_barrier(0); AT_MMK(fa, 4); __builtin_amdgcn_sched_barrier(0);
    if (MODE == 1) { LAS unsigned char* k2b = lds + AT_K2 + cur * 8192;
#define AT_LDK2(dst, s0) do { dst[0] = *(const LAS bf16x8*)(k2b + st.k2a[s0]); dst[1] = *(const LAS bf16x8*)(k2b + st.k2a[s0] + 4096); dst[2] = *(const LAS bf16x8*)(k2b + st.k2a[(s0) + 1]); dst[3] = *(const LAS bf16x8*)(k2b + st.k2a[(s0) + 1] + 4096); } while (0)
        AT_LDK2(fa, 0); __builtin_amdgcn_sched_barrier(0); AT_MMK(fb, 6); __builtin_amdgcn_sched_barrier(0);
        AT_LDK2(fb, 2); __builtin_amdgcn_sched_barrier(0); AT_MMK(fa, 8); __builtin_amdgcn_sched_barrier(0);
        AT_MMK(fb, 10);
#undef AT_LDK2
    } else { AT_MMK(fb, 6); }
    __builtin_amdgcn_sched_barrier(0);
#undef AT_LDK
#undef AT_MMK
    }
    if (full) return;
    const float NEG = -__builtin_inff();
    const bool rowok = (MODE == 0) ? (((rowmask >> j) & 1ull) != 0ull) : true;
    if (MODE == 0 && rowonly) {
#pragma unroll
        for (int i = 0; i < 16; ++i) { p0[i] = rowok ? p0[i] : NEG; p1[i] = rowok ? p1[i] : NEG; }
        return; }
#pragma unroll
    for (int i = 0; i < 16; ++i) { const int key0 = 64 * j + (i & 3) + 8 * (i >> 2) + 4 * (int)h, key1 = key0 + 32;
        bool ok0, ok1;
        if (MODE == 2) { ok0 = (16 * key0 + 31 <= t); ok1 = (16 * key1 + 31 <= t); }
        else { ok0 = rowok && ((unsigned)(t - key0) < W); ok1 = rowok && ((unsigned)(t - key1) < W); }
        p0[i] = ok0 ? p0[i] : NEG; p1[i] = ok1 ? p1[i] : NEG; }
}
template <int MODE> __device__ __forceinline__ void attn_pv(const AttnState<MODE>& st, LAS unsigned char* lds, int vbuf, const bf16x8 (&pb)[2][2], f32x16 (&o)[4]) {
    LAS unsigned char* vb = lds + AT_V + vbuf * 16384;
    if constexpr (MODE == 1) {
#pragma unroll
        for (int cc = 0; cc < 4; ++cc)
#pragma unroll
            for (int hs = 0; hs < 4; ++hs) {
                const s16x4 a0 = __builtin_amdgcn_ds_read_tr16_b64_v4i16((LAS s16x4*)(vb + st.va[cc][0] + (hs >> 1) * 8192 + (hs & 1) * 4096));
                const s16x4 a1 = __builtin_amdgcn_ds_read_tr16_b64_v4i16((LAS s16x4*)(vb + st.va[cc][1] + (hs >> 1) * 8192 + (hs & 1) * 4096));
                const bf16x8 vf = {a0[0], a0[1], a0[2], a0[3], a1[0], a1[1], a1[2], a1[3]};
                o[cc] = __builtin_amdgcn_mfma_f32_32x32x16_bf16(vf, pb[hs >> 1][hs & 1], o[cc], 0, 0, 0);
            }
        return;
    }
    s16x4 va0[4][2], va1[4][2];
#define AT_LDV(dst, cc) do { _Pragma("unroll") for (int hs = 0; hs < 4; ++hs) { \
        dst[hs][0] = __builtin_amdgcn_ds_read_tr16_b64_v4i16((LAS s16x4*)(vb + st.va[cc][0] + (hs >> 1) * 8192 + (hs & 1) * 4096)); \
        dst[hs][1] = __builtin_amdgcn_ds_read_tr16_b64_v4i16((LAS s16x4*)(vb + st.va[cc][1] + (hs >> 1) * 8192 + (hs & 1) * 4096)); } } while (0)
#define AT_MMV(src, cc) do { _Pragma("unroll") for (int hs = 0; hs < 4; ++hs) { \
        const bf16x8 vf = {src[hs][0][0], src[hs][0][1], src[hs][0][2], src[hs][0][3], src[hs][1][0], src[hs][1][1], src[hs][1][2], src[hs][1][3]}; \
        o[cc] = __builtin_amdgcn_mfma_f32_32x32x16_bf16(vf, pb[hs >> 1][hs & 1], o[cc], 0, 0, 0); } } while (0)
    AT_LDV(va0, 0); __builtin_amdgcn_sched_barrier(0);
    AT_LDV(va1, 1); __builtin_amdgcn_sched_barrier(0); AT_MMV(va0, 0); __builtin_amdgcn_sched_barrier(0);
    AT_LDV(va0, 2); __builtin_amdgcn_sched_barrier(0); AT_MMV(va1, 1); __builtin_amdgcn_sched_barrier(0);
    AT_LDV(va1, 3); __builtin_amdgcn_sched_barrier(0); AT_MMV(va0, 2); __builtin_amdgcn_sched_barrier(0);
    AT_MMV(va1, 3); __builtin_amdgcn_sched_barrier(0);
#undef AT_LDV
#undef AT_MMV
}
template <int MODE> __device__ __forceinline__ bool attn_tile_full(int j, int tmin, int tmax, u64 andmask, unsigned W) {
    if (MODE == 2) return 16 * (64 * j + 63) + 31 <= tmin;
    return (64 * j + 63 <= tmin) && ((unsigned)(tmax - 64 * j) < W) && (((andmask >> j) & 1ull) != 0ull);
}
constexpr float ATT_THR = 8.0f;
template <int MODE> __device__ __forceinline__ bool attn_tile_empty(int j, int tmin, int tmax, u64 ormask, unsigned W) {
    if (MODE == 2) return 16 * (64 * j) + 31 > tmax;
    return (64 * j > tmax) || ((unsigned)(tmin - (64 * j + 63)) >= W && tmin > 64 * j + 63) || (((ormask >> j) & 1ull) == 0ull);
}
template <int MODE> __device__ __forceinline__ void attn_tile(const AttnState<MODE>& st, LAS unsigned char* lds, int kbuf, int j, int lane, int t, u64 rowmask, unsigned W, float c2,
                                                             int tmin, int tmax, u64 andmask, u64 ormask, f32x16 (&o)[4], float& m, float& l) {
    if (attn_tile_empty<MODE>(j, tmin, tmax, ormask, W)) return;
    f32x16 p0, p1;
    attn_scores<MODE>(st, lds, kbuf, j, lane, t, rowmask, W, attn_tile_full<MODE>(j, tmin, tmax, andmask, W), (MODE == 0) && (64 * j + 63 <= tmin) && ((unsigned)(tmax - 64 * j) < W), p0, p1);
    float pmax = p0[0];
#pragma unroll
    for (int i = 1; i < 16; ++i) pmax = fmaxf(pmax, p0[i]);
#pragma unroll
    for (int i = 0; i < 16; ++i) pmax = fmaxf(pmax, p1[i]);
    { float pa, pb2; pair32(pmax, pa, pb2); asm("v_max_f32 %0, %1, %2" : "=v"(pmax) : "v"(pa), "v"(pb2)); }
    if (!__all((pmax - m) * c2 <= ATT_THR)) {
        const float mn = fmaxf(m, pmax), alpha = fexp2((m - mn) * c2); m = mn; l *= alpha;
#pragma unroll
        for (int cc = 0; cc < 4; ++cc) o[cc] = o[cc] * alpha;
    }
    const float nmb = -m * c2;
#pragma unroll
    for (int i = 0; i < 16; ++i) { p0[i] = fexp2(fma_s(p0[i], c2, nmb)); p1[i] = fexp2(fma_s(p1[i], c2, nmb)); }
    { float sv[16];
#pragma unroll
      for (int i = 0; i < 16; ++i) sv[i] = add_s(p0[i], p1[i]);
#pragma unroll
      for (int i = 0; i < 8; ++i) sv[i] = add_s(sv[i], sv[i + 8]);
#pragma unroll
      for (int i = 0; i < 4; ++i) sv[i] = add_s(sv[i], sv[i + 4]);
      float ps = add_s(add_s(sv[0], sv[1]), add_s(sv[2], sv[3]));
      { float pa, pb2; pair32(ps, pa, pb2); ps = pa + pb2; } l += ps; }
    bf16x8 pb[2][2];
    { u32x4 w;
      w.x = cvt_pk_bf16(p0[0], p0[1]); w.y = cvt_pk_bf16(p0[2], p0[3]); w.z = cvt_pk_bf16(p0[4], p0[5]); w.w = cvt_pk_bf16(p0[6], p0[7]); pb[0][0] = *(bf16x8*)&w;
      w.x = cvt_pk_bf16(p0[8], p0[9]); w.y = cvt_pk_bf16(p0[10], p0[11]); w.z = cvt_pk_bf16(p0[12], p0[13]); w.w = cvt_pk_bf16(p0[14], p0[15]); pb[0][1] = *(bf16x8*)&w;
      w.x = cvt_pk_bf16(p1[0], p1[1]); w.y = cvt_pk_bf16(p1[2], p1[3]); w.z = cvt_pk_bf16(p1[4], p1[5]); w.w = cvt_pk_bf16(p1[6], p1[7]); pb[1][0] = *(bf16x8*)&w;
      w.x = cvt_pk_bf16(p1[8], p1[9]); w.y = cvt_pk_bf16(p1[10], p1[11]); w.z = cvt_pk_bf16(p1[12], p1[13]); w.w = cvt_pk_bf16(p1[14], p1[15]); pb[1][1] = *(bf16x8*)&w; }
    attn_pv<MODE>(st, lds, kbuf, pb, o);
}
template <int MODE> __device__ __forceinline__ void attn_core(const AttnState<MODE>& st, LAS unsigned char* lds, int tid, int lane, int t, u64 rowmask, const AttnSrc& S, u64 need, unsigned W, float c2,
                                                             int tmin, int tmax, u64 andmask, u64 ormask, f32x16 (&o)[4], float& m, float& l) {
#pragma unroll
    for (int cc = 0; cc < 4; ++cc)
#pragma unroll
        for (int i = 0; i < 16; ++i) o[cc][i] = 0.f;
    m = -1.0e30f; l = 0.f;
    __syncthreads();
    if (need == 0ull) return;
    if constexpr (MODE == 1) {
        int j = __builtin_ctzll(need); need &= need - 1ull;
        u32x4 kreg[2], vreg[2], k2reg = (u32x4){0u, 0u, 0u, 0u};
        attn_issue<MODE>(S, j, tid, kreg, k2reg, vreg, true);
        for (;;) {
            attn_write<MODE>(lds, 0, tid, kreg, k2reg, vreg, true);
            __syncthreads();
            bool more = (need != 0ull); int jn = 0;
            if (more) { jn = __builtin_ctzll(need); need &= need - 1ull; attn_issue<MODE>(S, jn, tid, kreg, k2reg, vreg, true); }
            attn_tile<MODE>(st, lds, 0, j, lane, t, rowmask, W, c2, tmin, tmax, andmask, ormask, o, m, l);
            if (!more) break;
            j = jn;
            attn_write<MODE>(lds, 1, tid, kreg, k2reg, vreg, true);
            __syncthreads();
            more = (need != 0ull);
            if (more) { jn = __builtin_ctzll(need); need &= need - 1ull; attn_issue<MODE>(S, jn, tid, kreg, k2reg, vreg, true); }
            attn_tile<MODE>(st, lds, 1, j, lane, t, rowmask, W, c2, tmin, tmax, andmask, ormask, o, m, l);
            if (!more) break;
            j = jn;
        }
        return;
    }
    u32x4 kA[2], vA[2], k2A = (u32x4){0u, 0u, 0u, 0u}, kB[2], vB[2], k2B = (u32x4){0u, 0u, 0u, 0u};
    int jA = __builtin_ctzll(need); need &= need - 1ull;
    attn_issue<MODE>(S, jA, tid, kA, k2A, vA, true);
    int jB = -1;
    if (need != 0ull) { jB = __builtin_ctzll(need); need &= need - 1ull; attn_issue<MODE>(S, jB, tid, kB, k2B, vB, true); }
    for (;;) {
        attn_write<MODE>(lds, 0, tid, kA, k2A, vA, true);
        __syncthreads();
        const int j0 = jA;
        if (need != 0ull) { jA = __builtin_ctzll(need); need &= need - 1ull; attn_issue<MODE>(S, jA, tid, kA, k2A, vA, true); } else jA = -1;
        attn_tile<MODE>(st, lds, 0, j0, lane, t, rowmask, W, c2, tmin, tmax, andmask, ormask, o, m, l);
        if (jB < 0) break;
        attn_write<MODE>(lds, 1, tid, kB, k2B, vB, true);
        __syncthreads();
        const int j1 = jB;
        if (need != 0ull) { jB = __builtin_ctzll(need); need &= need - 1ull; attn_issue<MODE>(S, jB, tid, kB, k2B, vB, true); } else jB = -1;
        attn_tile<MODE>(st, lds, 1, j1, lane, t, rowmask, W, c2, tmin, tmax, andmask, ormask, o, m, l);
        if (jA < 0) break;
    }
}
__device__ __forceinline__ void swap32(unsigned& a, unsigned& b) { asm volatile("s_nop 1\n\tv_permlane32_swap_b32 %0, %1" : "+v"(a), "+v"(b)); }
__device__ __forceinline__ void store_pair(bf16* p, u32x2 a, u32x2 b) { unsigned ax = a.x, ay = a.y, bx = b.x, by = b.y; swap32(ax, bx); swap32(ay, by); u32x4 w; w.x = ax; w.y = ay; w.z = bx; w.w = by; *(u32x4*)p = w; }
__device__ __forceinline__ void load_pair(const bf16* p, u32x2& a, u32x2& b) { const u32x4 w = *(const u32x4*)p; unsigned ax = w.x, ay = w.y, bx = w.z, by = w.w; swap32(ax, bx); swap32(ay, by); a.x = ax; a.y = ay; b.x = bx; b.y = by; }
__device__ __forceinline__ void attn_store(const f32x16 (&o)[4], float l, int lane, bf16* orow) {
    const float inv = l > 0.f ? 1.0f / l : 0.f; const int hi = lane >> 5;
#pragma unroll
    for (int cc = 0; cc < 4; ++cc)
#pragma unroll
        for (int q = 0; q < 2; ++q) { u32x2 w[2];
#pragma unroll
            for (int k = 0; k < 2; ++k) { const int g4 = 2 * q + k; w[k].x = cvt_pk_bf16(o[cc][4 * g4] * inv, o[cc][4 * g4 + 1] * inv); w[k].y = cvt_pk_bf16(o[cc][4 * g4 + 2] * inv, o[cc][4 * g4 + 3] * inv); }
            store_pair(orow + 32 * cc + 16 * q + 8 * hi, w[0], w[1]); }
}

constexpr float C2_NSA = 0.08838834764831845f * 1.4426950408889634f;
constexpr float C2_MLA = 0.07216878364870322f * 1.4426950408889634f;

template <int KIND> __device__ __forceinline__ void nsa_unit(const Ctx& c, int idx) {
    const Lane L = mk_lane(c);
    const int chunk = idx >> 2, b = (idx >> 1) & 1, g = idx & 1;
    const int lane = L.lane, cq = lane & 31, ql = 8 * L.wave + (cq & 7), hh = cq >> 3, t = 64 * chunk + ql, head = 4 * g + hh;
    const bf16* Qn = (const bf16*)(c.ws + WS_QN);
    const size_t rowi = ((size_t)(b * SEQ + t) * 8 + head) * HD;
    AttnSrc S; S.K2 = nullptr; S.k2s = 0; S.ks = HD; S.vs = HD;
    const size_t kvoff = (size_t)(b * NG + g) * SEQ * HD;
    u64 rowmask = ~0ull, need;
    LAS u64* ctl64 = (LAS u64*)(c.lds + AT_CTL);
    if (KIND == 0) {
        S.K = (const bf16*)(c.ws + WS_NSAKV + 2 * NSAKV_ONE) + kvoff; S.V = (const bf16*)(c.ws + WS_NSAKV + 3 * NSAKV_ONE) + kvoff;
        const u64* sm = (const u64*)(c.ws + WS_TAB + TAB_SELMASK) + (size_t)(b * NG + g) * SEQ;
        rowmask = sm[t];
        __syncthreads();
        if (L.tid < 64) { u64 mm = sm[64 * chunk + L.tid]; unsigned lo = (unsigned)mm, hi2 = (unsigned)(mm >> 32);
#pragma unroll
            for (int o2 = 1; o2 < 64; o2 <<= 1) { lo |= shx(lo, o2); hi2 |= shx(hi2, o2); }
            if (L.tid == 0) ctl64[0] = ((u64)hi2 << 32) | lo; }
        __syncthreads();
        need = ctl64[0];
        need &= (chunk == 63) ? ~0ull : ((1ull << (chunk + 1)) - 1ull);
    } else {
        S.K = (const bf16*)(c.ws + WS_NSAKV + 4 * NSAKV_ONE) + kvoff; S.V = (const bf16*)(c.ws + WS_NSAKV + 5 * NSAKV_ONE) + kvoff;
        const int lo = chunk - 8 > 0 ? chunk - 8 : 0;
        const u64 upto = (chunk == 63) ? ~0ull : ((1ull << (chunk + 1)) - 1ull);
        need = upto & ~((1ull << lo) - 1ull);
    }
    { const unsigned nlo = __builtin_amdgcn_readfirstlane((unsigned)need), nhi = __builtin_amdgcn_readfirstlane((unsigned)(need >> 32)); need = ((u64)nhi << 32) | nlo; }
    AttnState<0> st; attn_setup<0>(st, lane, Qn + rowi);
    f32x16 o[4]; float m, l;
    u64 andmask = ~0ull, ormask = ~0ull;
    if (KIND == 0) { unsigned lo = (unsigned)rowmask, hi2 = (unsigned)(rowmask >> 32);
#pragma unroll
        for (int o2 = 1; o2 < 64; o2 <<= 1) { lo &= shx(lo, o2); hi2 &= shx(hi2, o2); }
        andmask = ((u64)__builtin_amdgcn_readfirstlane(hi2) << 32) | __builtin_amdgcn_readfirstlane(lo);
        lo = (unsigned)rowmask; hi2 = (unsigned)(rowmask >> 32);
#pragma unroll
        for (int o2 = 1; o2 < 64; o2 <<= 1) { lo |= shx(lo, o2); hi2 |= shx(hi2, o2); }
        ormask = ((u64)__builtin_amdgcn_readfirstlane(hi2) << 32) | __builtin_amdgcn_readfirstlane(lo); }
    const int tmin = 64 * chunk + 8 * L.wave;
    attn_core<0>(st, c.lds, L.tid, lane, t, rowmask, S, need, KIND == 0 ? 0x7fffffffu : 512u, C2_NSA, tmin, tmin + 7, andmask, ormask, o, m, l);
    if (KIND == 1) attn_store(o, l, lane, (bf16*)(c.ws + WS_OW) + rowi);
    else {
        const float* gn = (const float*)(c.ws + WS_GNSA) + (size_t)(b * SEQ + t) * 24 + head;
        const float g0 = gn[0], g1 = gn[8] * (l > 0.f ? 1.0f / l : 0.f), g2 = gn[16]; const int hi = lane >> 5;
        const bf16* Oc = (const bf16*)(c.ws + WS_OC) + rowi; const bf16* Ow = (const bf16*)(c.ws + WS_OW) + rowi; bf16* Oa = (bf16*)(c.ws + WS_OA) + (size_t)(b * SEQ + t) * 2048 + head * HD;
#pragma unroll
        for (int cc = 0; cc < 4; ++cc)
#pragma unroll
            for (int q = 0; q < 2; ++q) { const int dq = 32 * cc + 16 * q + 8 * hi; u32x2 wcp[2], wwp[2], wo[2];
                load_pair(Oc + dq, wcp[0], wcp[1]); load_pair(Ow + dq, wwp[0], wwp[1]);
#pragma unroll
                for (int k = 0; k < 2; ++k) { const int g4 = 2 * q + k; const u32x2 wc = wcp[k], ww = wwp[k];
                    const float r0 = g0 * bflo(wc.x) + g2 * bflo(ww.x) + g1 * o[cc][4 * g4], r1 = g0 * bfhi(wc.x) + g2 * bfhi(ww.x) + g1 * o[cc][4 * g4 + 1];
                    const float r2 = g0 * bflo(wc.y) + g2 * bflo(ww.y) + g1 * o[cc][4 * g4 + 2], r3 = g0 * bfhi(wc.y) + g2 * bfhi(ww.y) + g1 * o[cc][4 * g4 + 3];
                    wo[k].x = cvt_pk_bf16(r0, r1); wo[k].y = cvt_pk_bf16(r2, r3); }
                store_pair(Oa + dq, wo[0], wo[1]); }
    }
}
__device__ __forceinline__ void mla_unit(const Ctx& c, int idx) {
    const Lane L = mk_lane(c);
    const int qb = idx >> 4, b = (idx >> 3) & 1, h = idx & 7;
    const int lane = L.lane, t = 256 * qb + 32 * L.wave + (lane & 31);
    const bf16* Qm = (const bf16*)(c.ws + WS_QM);
    AttnSrc S; S.K = (const bf16*)(c.ws + WS_KM) + ((size_t)(b * 8 + h) * SEQ) * HD; S.ks = HD;
    S.K2 = (const bf16*)(c.ws + WS_KR) + (size_t)b * SEQ * 64; S.k2s = 64;
    S.V = (const bf16*)(c.ws + WS_VM) + ((size_t)(b * 8 + h) * SEQ) * HD; S.vs = HD;
    const u64 need = (qb == 15) ? ~0ull : ((1ull << (4 * qb + 4)) - 1ull);
    AttnState<1> st; attn_setup<1>(st, lane, Qm + ((size_t)(b * SEQ + t) * 8 + h) * 192);
    f32x16 o[4]; float m, l;
    const int tmin = 256 * qb + 32 * L.wave;
    attn_core<1>(st, c.lds, L.tid, lane, t, ~0ull, S, need, 0x7fffffffu, C2_MLA, tmin, tmin + 31, ~0ull, ~0ull, o, m, l);
    attn_store(o, l, lane, (bf16*)(c.ws + WS_OA) + (size_t)(b * SEQ + t) * 2048 + 1024 + h * HD);
}
__device__ __forceinline__ void cmp_unit(const Ctx& c, int idx) {
    const Lane L = mk_lane(c);
    const int chunk = idx >> 2, b = (idx >> 1) & 1, g = idx & 1;
    const int lane = L.lane, cq = lane & 31, hi = lane >> 5, ql = 8 * L.wave + (cq & 7), hh = cq >> 3, t = 64 * chunk + ql, head = 4 * g + hh;
    const bf16* Qn = (const bf16*)(c.ws + WS_QN);
    const size_t rowi = ((size_t)(b * SEQ + t) * 8 + head) * HD;
    AttnSrc S; S.K2 = nullptr; S.k2s = 0; S.ks = HD; S.vs = HD;
    S.K = (const bf16*)(c.ws + WS_KC) + (size_t)(b * NG + g) * 256 * HD; S.V = (const bf16*)(c.ws + WS_VC) + (size_t)(b * NG + g) * 256 * HD;
    const int jmax = (4 * chunk + 2) >> 6;
    const u64 need = (1ull << (jmax + 1)) - 1ull;
    AttnState<2> st; attn_setup<2>(st, lane, Qn + rowi);
    f32x16 o[4]; float m, l;
    const int tmin = 64 * chunk + 8 * L.wave;
    attn_core<2>(st, c.lds, L.tid, lane, t, ~0ull, S, need, 0u, C2_NSA, tmin, tmin + 7, ~0ull, ~0ull, o, m, l);
    attn_store(o, l, lane, (bf16*)(c.ws + WS_OC) + rowi);
    LAS float* IMP = (LAS float*)(c.lds + AT_IMP);
    const float inv = l > 0.f ? 1.0f / l : 0.f, mb = m * C2_NSA;
    float carry = 0.f;
    __syncthreads();
    for (int j = 0; j <= jmax; ++j) {
        u32x4 kreg[2], vreg[2], k2reg = (u32x4){0u, 0u, 0u, 0u};
        attn_issue<2>(S, j, L.tid, kreg, k2reg, vreg, false);
        attn_write<2>(c.lds, j & 1, L.tid, kreg, k2reg, vreg, false);
        __syncthreads();
        f32x16 p0, p1;
        attn_scores<2>(st, c.lds, j & 1, j, lane, t, ~0ull, 0u, false, false, p0, p1);
#pragma unroll
        for (int i = 0; i < 16; ++i) { p0[i] = fexp2(fma_s(p0[i], C2_NSA, -mb)) * inv; p1[i] = fexp2(fma_s(p1[i], C2_NSA, -mb)) * inv; }
        float ol0[4], ol1[4];
#pragma unroll
        for (int gg = 0; gg < 4; ++gg) { ol0[gg] = shx(p0[4 * gg + 3], 32); ol1[gg] = shx(p1[4 * gg + 3], 32); }
        float im0[4], im1[4];
#pragma unroll
        for (int gg = 0; gg < 4; ++gg) {
            const float a0 = hi ? ol0[gg] : (gg == 0 ? carry : ol0[gg > 0 ? gg - 1 : 0]);
            const float a1 = hi ? ol1[gg] : (gg == 0 ? ol0[3] : ol1[gg > 0 ? gg - 1 : 0]);
            float v0 = (p0[4 * gg] + p0[4 * gg + 1]) + (p0[4 * gg + 2] + p0[4 * gg + 3]) + a0;
            float v1 = (p1[4 * gg] + p1[4 * gg + 1]) + (p1[4 * gg + 2] + p1[4 * gg + 3]) + a1;
            v0 += shx(v0, 8); v0 += shx(v0, 16); v1 += shx(v1, 8); v1 += shx(v1, 16);
            im0[gg] = v0; im1[gg] = v1; }
        carry = ol1[3];
        if (hh == 0) {
#pragma unroll
            for (int gg = 0; gg < 4; ++gg) { IMP[ql * 65 + 16 * j + 2 * gg + hi] = im0[gg]; IMP[ql * 65 + 16 * j + 8 + 2 * gg + hi] = im1[gg]; } }
    }
    __syncthreads();
    u64* sm = (u64*)(c.ws + WS_TAB + TAB_SELMASK) + (size_t)(b * NG + g) * SEQ;
    const int cur = chunk, jj = lane;
    for (int qi = 0; qi < 8; ++qi) {
        const int q = 8 * L.wave + qi;
        const bool cand = (jj >= 1) && (jj <= cur - 2);
        const float w = IMP[q * 65 + jj];
        const float v = cand ? w : 0.f;
        int rank = 0;
        for (int k = 1; k <= cur - 2; ++k) { const float vk = __builtin_bit_cast(float, __builtin_amdgcn_readlane(__builtin_bit_cast(int, w), k)); rank += (vk > v || (vk == v && k < jj)) ? 1 : 0; }
        const bool sel = (jj <= cur) && (jj == 0 || jj >= cur - 1 || (cand && rank < 13));
        const u64 mask = __ballot(sel);
        if (lane == 0) sm[64 * chunk + q] = mask;
    }
    __syncthreads();
}

__device__ __forceinline__ void nsa_merge_phase(const Ctx& c) {
    const Lane L = mk_lane(c);
    const bf16* Oc = (const bf16*)(c.ws + WS_OC); const bf16* Os = (const bf16*)(c.ws + WS_OS); const bf16* Ow = (const bf16*)(c.ws + WS_OW);
    const float* gn = (const float*)(c.ws + WS_GNSA); bf16* Oa = (bf16*)(c.ws + WS_OA);
    const int lane = L.lane, hh = lane >> 3;
    for (int row = L.gw; row < T; row += L.NGW) {
        const size_t off = (size_t)row * 1024 + lane * 16;
        const float g0 = gn[(size_t)row * 24 + hh], g1 = gn[(size_t)row * 24 + 8 + hh], g2 = gn[(size_t)row * 24 + 16 + hh];
        float a[16], b2[16], d[16];
        load16(Oc + off, a); load16(Os + off, b2); load16(Ow + off, d);
#pragma unroll
        for (int i = 0; i < 16; ++i) a[i] = g0 * a[i] + g1 * b2[i] + g2 * d[i];
        store16(Oa + off, a);
    }
}

__device__ __forceinline__ void moe_slots_phase(const Ctx& c) {
    const Lane L = mk_lane(c);
    const f32x4* route = (const f32x4*)(c.ws + WS_TAB + TAB_ROUTE);
    int* slot_tok = (int*)(c.ws + WS_TAB + TAB_SLOTTOK); float* slot_gate = (float*)(c.ws + WS_TAB + TAB_SLOTGATE); int* blk_exp = (int*)(c.ws + WS_TAB + TAB_BLKEXP);
    const bf16* hn = (const bf16*)(c.ws + WS_HN); bf16* Ag = (bf16*)(c.ws + WS_AG);
    LAS int* cnt = (LAS int*)(c.lds);
    const int per = T / c.G;
    const int t0 = c.vcu * per;
    __syncthreads();
    if (L.tid < 16) cnt[L.tid] = 0;
    __syncthreads();
    { int pre[8], tot[8];
#pragma unroll
      for (int e = 0; e < 8; ++e) { pre[e] = 0; tot[e] = 0; }
      for (int t = L.tid; t < T; t += 512) { const f32x4 r = route[t]; const int e0 = __float_as_int(r[0]), e1 = __float_as_int(r[1]); const bool before = t < t0;
#pragma unroll
          for (int e = 0; e < 8; ++e) { const int hit = (e0 == e ? 1 : 0) + (e1 == e ? 1 : 0); tot[e] += hit; pre[e] += before ? hit : 0; } }
#pragma unroll
      for (int e = 0; e < 8; ++e) {
#pragma unroll
          for (int o = 1; o < 64; o <<= 1) { pre[e] += shx(pre[e], o); tot[e] += shx(tot[e], o); }
          if (L.lane == 0) { atomicAdd((int*)&cnt[e], pre[e]); atomicAdd((int*)&cnt[8 + e], tot[e]); } } }
    __syncthreads();
    int pstart[8]; int acc = 0;
#pragma unroll
    for (int e = 0; e < 8; ++e) { pstart[e] = acc; acc += (cnt[8 + e] + 255) & ~255; }
    const int n_used = acc >> 8;
    int base[8];
#pragma unroll
    for (int e = 0; e < 8; ++e) base[e] = pstart[e] + cnt[e];
    for (int tc = 0; tc < per; tc += 32) {
        __syncthreads();
        { const int t = t0 + tc + (L.lane >> 1), k = L.lane & 1; const f32x4 r = route[t]; const int e = __float_as_int(k ? r[1] : r[0]); const float gt = k ? r[3] : r[2];
            int slot = 0;
#pragma unroll
            for (int ee = 0; ee < 8; ++ee) { const u64 bm = __ballot(e == ee); const int rk = __popcll(bm & ((1ull << L.lane) - 1ull)); if (e == ee) slot = base[ee] + rk; base[ee] += __popcll(bm); }
            if (L.wave == 0) { slot_tok[slot] = t; slot_gate[slot] = gt; cnt[16 + L.lane] = slot; ((int*)(c.ws + WS_TAB + TAB_TOKSLOT))[2 * t + k] = slot; } }
        __syncthreads();
        for (int i = 0; i < 8; ++i) { const int a2 = L.wave * 8 + i, t = t0 + tc + (a2 >> 1), slot = cnt[16 + a2];
            const u32x4* src = (const u32x4*)(hn + (size_t)t * DM); u32x4* dst = (u32x4*)((unsigned char*)Ag + (size_t)slot * DM);
#pragma unroll
            for (int q = 0; q < 2; ++q) { const int ix = L.lane + 64 * q; float a8[8], b8[8]; unpack8(src[2 * ix], a8); unpack8(src[2 * ix + 1], b8);
#pragma unroll
                for (int e = 0; e < 8; ++e) { a8[e] *= F8_A_SCALE; b8[e] *= F8_A_SCALE; }
                u32x4 w; w.x = pk4_f8(a8[0], a8[1], a8[2], a8[3]); w.y = pk4_f8(a8[4], a8[5], a8[6], a8[7]); w.z = pk4_f8(b8[0], b8[1], b8[2], b8[3]); w.w = pk4_f8(b8[4], b8[5], b8[6], b8[7]);
                dst[ix] = w; } }
    }
    if (c.vcu < 8) { const int e = c.vcu, n = cnt[8 + e], pe = (n + 255) & ~255; for (int i = n + L.tid; i < pe; i += 512) { slot_tok[pstart[e] + i] = -1; slot_gate[pstart[e] + i] = 0.f; } }
    if (c.vcu == 8 % c.G && L.tid < 73) { int v;
        if (L.tid == 72) v = n_used; else { const int s0 = L.tid * 256; v = 7;
#pragma unroll
            for (int e = 7; e >= 0; --e) if (s0 < pstart[e] + ((cnt[8 + e] + 255) & ~255)) v = e; }
        blk_exp[L.tid] = v; }
    __syncthreads();
}

__device__ __forceinline__ void moe_combine_phase(const Ctx& c, const bf16* x1, float* out) {
    const Lane L = mk_lane(c);
    const int* be = (const int*)(c.ws + WS_TAB + TAB_BLKEXP); const int nM = __builtin_amdgcn_readfirstlane(be[72]);
    int n_full, ks; pg8::Order::tail_params(nM * (DM / 256), c.G, DFF / 128, n_full, ks);
    const int* tokslot = (const int*)(c.ws + WS_TAB + TAB_TOKSLOT);
    const bf16* Y0 = (const bf16*)(c.ws + WS_Y0); const bf16* Yt = (const bf16*)(c.ws + WS_YT);
    for (int row = L.gw; row < T; row += L.NGW) {
        const int s0 = __builtin_amdgcn_readfirstlane(tokslot[2 * row]), s1 = __builtin_amdgcn_readfirstlane(tokslot[2 * row + 1]);
        f32x4* o = (f32x4*)(out + (size_t)row * DM) + L.lane; const u32x2* xi = (const u32x2*)(x1 + (size_t)row * DM) + L.lane;
#pragma unroll
        for (int j = 0; j < 8; ++j) {
            const u32x2 xw = xi[64 * j]; f32x4 v = (f32x4){bflo(xw.x), bfhi(xw.x), bflo(xw.y), bfhi(xw.y)};
#pragma unroll
            for (int q = 0; q < 2; ++q) { const int sl = q ? s1 : s0; { const u32x2 yw = ((const u32x2*)(Y0 + (size_t)sl * DM))[L.lane + 64 * j]; v += (f32x4){bflo(yw.x), bfhi(yw.x), bflo(yw.y), bfhi(yw.y)}; }
                const int wg = pg8::Order::tile_wgid(nM, DM / 256, sl >> 8, j);
                if (wg >= n_full) for (int p = 1; p < ks; ++p) { const u32x2 yw = ((const u32x2*)(Yt + (size_t)((wg - n_full) * (ks - 1) + p - 1) * 65536 + (size_t)(sl & 255) * 256))[L.lane]; v += (f32x4){bflo(yw.x), bfhi(yw.x), bflo(yw.y), bfhi(yw.y)}; } }
            o[64 * j] = v; }
    }
}

__device__ __forceinline__ bool phase_fence(Ctx& c) { asm volatile("" : "+s"(c.ws)); return true; }
__global__ void __launch_bounds__(512, 2) fwd_kernel(Args args) {
    extern __shared__ __attribute__((aligned(16))) unsigned char lds_raw[];
    Ctx c;
    c.lds = (LAS unsigned char*)lds_raw; c.ws = (GAS unsigned char*)args.ws; c.ctl = (unsigned*)(args.ws + WS_CTL);
    { int w = __builtin_amdgcn_readfirstlane((int)threadIdx.x >> 6); asm volatile("" : "+s"(w)); c.wv = w; }
    c.G = gridDim.x; { const int bx = blockIdx.x; c.vcu = (c.G % 8 == 0) ? (bx % 8) * (c.G / 8) + bx / 8 : bx; }
    volatile LAS unsigned* MISC = (volatile LAS unsigned*)(c.lds + MISC_OFF);
    for (int u = fresh_tid(c.wv); u < (LDS_BYTES - RING_BYTES) / 4; u += 512) ((LAS unsigned*)(c.lds + RING_BYTES))[u] = 0u;
    __syncthreads();
    XcdBarrier bar; bar.bar = c.ctl + CW_BAR; bar.x = 0; bar.st = nullptr;
#if MK_ONE_LAUNCH
    bar = xcd_barrier_post(c.ctl + CW_BAR, MISC + 8, c.wv);
#define GRID_BAR() xcd_barrier(bar)
#else
#define GRID_BAR() do { } while (0)
#endif
    const int lo = args.ph_lo, hi = args.ph_hi;
#if MK_ONE_LAUNCH
#define IN(k) (phase_fence(c), true)
#else
#define IN(k) (phase_fence(c), lo <= (k) && (k) < hi)
#endif
#define SEAM(k) do { if (IN(k) && IN((k) + 1)) GRID_BAR(); } while (0)
    LAS unsigned char* lds = c.lds;
    const int bx = (int)blockIdx.x;

    for (int rep = 0; rep < NREP(0); ++rep) { if (rep) GRID_BAR();
        if (IN(0)) { p0_prologue(args, c); norm_phase<false>(c, args.in[0], args.in[1], (bf16*)(c.ws + WS_HN), nullptr, nullptr); }
        }
    SEAM(0);

    for (int l = 0; l < 2; ++l) {
        const int P = 1 + 13 * l;
        unsigned char* wl = (unsigned char*)(c.ws + WS_WL + (size_t)l * WL_STRIDE);
        bf16* x1 = (l == 0) ? (bf16*)(c.ws + WS_X1) : (bf16*)(c.ws + WS_XA);
        bf16* hn = (bf16*)(c.ws + WS_HN);
        bf16* z = (bf16*)(c.ws + WS_Z);

        for (int rep = 0; rep < NREP(1); ++rep) { if (rep) GRID_BAR();
        if (IN(P + 1)) { pg8::Gemm g{hn, DM, (const bf16*)(wl + WL_IN), DM}; pg8::Order S; S.init(T / 256, DINP / 256, c.G, bx, DM); S.rot = (c.G == 256);
            const float* tabf = (const float*)(c.ws + WS_TAB);
            pg8::EpiInProj E{z, (l == 1) ? (const float*)(c.ws + WS_SSP + MiB) : nullptr, (bf16*)(c.ws + WS_QN), (unsigned char*)(c.ws + WS_NSAKV), (float*)(c.ws + WS_SSQ), (float*)(c.ws + WS_SSKV),
                             args.in[3] + l * 128, args.in[4] + l * 384, tabf + TAB_COS_TOK / 4, tabf + TAB_SIN_TOK / 4, (LAS float*)(lds + RING_BYTES + 2048),
                             (bf16*)(c.ws + WS_KR), (float*)(c.ws + WS_GNSA), args.in[16] + l * 64, tabf + TAB_COS_MLA / 4, tabf + TAB_SIN_MLA / 4};
            pg8::gemm_phase(lds, c.wv, g, S, E); }
        }
        SEAM(P + 1);
        for (int rep = 0; rep < NREP(7); ++rep) { if (rep) GRID_BAR();
        if (IN(P + 3)) {
            const bool part = (c.G >= 128);
            if (part) { if (bx < 64) compress_phase(c, args, l, bx, 64); } else compress_phase(c, args, l, c.vcu, c.G);
            { pg8::Gemm g{z + ZQA, DINP, (const bf16*)(wl + WL_QB), QLORA}; pg8::Order S; if (part) S.init(T / 256, 1536 / 256, c.G - 64, bx >= 64 ? bx - 64 : (1 << 20), QLORA); else S.init(T / 256, 1536 / 256, c.G, bx, QLORA); const float* tabf = (const float*)(c.ws + WS_TAB); pg8::EpiQb E{(bf16*)(c.ws + WS_QM), (const float*)(c.ws + WS_SSQ), args.in[13] + l * 128, args.in[14] + l * 64, tabf + TAB_COS_MLA / 4, tabf + TAB_SIN_MLA / 4, (LAS float*)(lds + RING_BYTES + 2048)}; pg8::gemm_phase(lds, c.wv, g, S, E); }
            { pg8::Gemm g{z + ZKVA, DINP, (const bf16*)(wl + WL_KVB), KVLORA}; pg8::Order S; S.init(T / 256, 2048 / 256, c.G, bx, KVLORA); pg8::EpiKvb E{(bf16*)(c.ws + WS_KM), (bf16*)(c.ws + WS_VM), (const float*)(c.ws + WS_SSKV), args.in[15] + l * 128, (LAS float*)(lds + RING_BYTES + 2048)}; pg8::gemm_phase(lds, c.wv, g, S, E); }
        }
        }
        SEAM(P + 3);
        for (int rep = 0; rep < NREP(9); ++rep) { if (rep) GRID_BAR();
        if (IN(P + 4)) {
            for (int u = c.vcu; u < 256; u += c.G) { cmp_unit(c, 255 - u); nsa_unit<1>(c, u); }
        }
        }
        SEAM(P + 4);
        for (int rep = 0; rep < NREP(4); ++rep) { if (rep) GRID_BAR();
        if (IN(P + 5)) {
            const int* order = (const int*)(c.ws + WS_TAB + TAB_ORDER);
            unsigned* qhead = c.ctl + CW_QUEUE + 64 * (l + 2 * rep);
            const int C = (l == 0) ? args.nch0 : args.nch_total - args.nch0, cbase = (l == 0) ? 0 : args.nch0;
            unsigned* chead = c.ctl + CW_QUEUE + 64 * (8 + l);
            unsigned* cact = c.ctl + CW_QUEUE + 64 * (12 + l);
            bool conv_left = true, attn_left = true;
            for (;;) {
                __syncthreads();
                if (fresh_tid(c.wv) == 0) { int r = -1;
                    if (conv_left) { const unsigned act = __hip_atomic_fetch_add(cact, 1u, __ATOMIC_RELAXED, __HIP_MEMORY_SCOPE_AGENT);
                        if (act < (unsigned)CONV_LIMIT || !attn_left) { const unsigned ch = __hip_atomic_fetch_add(chead, 1u, __ATOMIC_RELAXED, __HIP_MEMORY_SCOPE_AGENT); r = ch < (unsigned)C ? (int)ch : -2; }
                        if (r < 0) __hip_atomic_fetch_sub(cact, 1u, __ATOMIC_RELAXED, __HIP_MEMORY_SCOPE_AGENT); }
                    MISC[16] = (unsigned)r; }
                __syncthreads();
                const int r = (int)__builtin_amdgcn_readfirstlane(MISC[16]);
                if (r >= 0) { conv_chunk(args, c, cbase + r); __syncthreads(); if (fresh_tid(c.wv) == 0) __hip_atomic_fetch_sub(cact, 1u, __ATOMIC_RELAXED, __HIP_MEMORY_SCOPE_AGENT); continue; }
                if (r == -2) conv_left = false;
                if (attn_left) {
                    __syncthreads();
                    if (fresh_tid(c.wv) == 0) MISC[17] = __hip_atomic_fetch_add(qhead, 1u, __ATOMIC_RELAXED, __HIP_MEMORY_SCOPE_AGENT);
                    __syncthreads();
                    const int it = (int)__builtin_amdgcn_readfirstlane(MISC[17]);
                    if (it >= 512) attn_left = false;
                    else { const int id = __builtin_amdgcn_readfirstlane(order[it]), kind = id >> 8, idx = id & 255;
                        if (kind == 0) mla_unit(c, idx); else nsa_unit<0>(c, idx); }
                }
                if (!attn_left && !conv_left) break;
            }
        }
        }
        SEAM(P + 5);

        for (int rep = 0; rep < NREP(8); ++rep) { if (rep) GRID_BAR();
        if (IN(P + 7)) {
            { pg8::Gemm g{(const bf16*)(c.ws + WS_OA), 2048, (const bf16*)(wl + WL_PA), 2048}; pg8::Order S; S.init(T / 256, DM / 256, c.G, bx, 2048); pg8::EpiGateMix E{(bf16*)(c.ws + WS_MIX), z}; pg8::gemm_phase(lds, c.wv, g, S, E); }
        }
        }
        SEAM(P + 7);
        for (int rep = 0; rep < NREP(3); ++rep) { if (rep) GRID_BAR();
        if (IN(P + 8)) { pg8::Gemm g{(const bf16*)(c.ws + WS_MIX), DM, (const bf16*)(wl + WL_OUT), DM}; pg8::Order S; S.init(T / 256, DM / 256, c.G, bx, DM);
            if (l == 0) { pg8::EpiRes<true> E{x1, args.in[0], args.in[20], hn, (float*)(c.ws + WS_SSP)}; pg8::gemm_phase(lds, c.wv, g, S, E); }
            else { pg8::EpiRes<false> E{x1, (const void*)(c.ws + WS_XA), args.in[20], nullptr, (float*)(c.ws + WS_SSP)}; pg8::gemm_phase(lds, c.wv, g, S, E); } }
        }
        SEAM(P + 8);
if (l == 1) {
            if (IN(P + 9)) norm_phase<true, true>(c, x1, args.in[20] + l * DM, hn, args.in[24], (float*)(c.ws + WS_TAB + TAB_ROUTE));
            SEAM(P + 9); }
        if (IN(P + 10)) { if (l == 1) moe_slots_phase(c); }
        if (l == 1) SEAM(P + 10);
        for (int rep = 0; rep < ((l == 0) ? NREP(5) : 1); ++rep) { if (rep) GRID_BAR();
        for (int rep2 = 0; rep2 < ((l == 1) ? NREP(6) : 1); ++rep2) { if (rep2) GRID_BAR();
        if (IN(P + 11)) {
            if (l == 0) { pg8::Gemm g{hn, DM, (const bf16*)(c.ws + WS_W13D), DM}; pg8::Order S; S.init(T / 256, 2 * DFF / 256, c.G, bx, DM); pg8::EpiSwiglu E{(void*)(c.ws + WS_H), (const float*)(c.ws + WS_SSP), 1.0f}; pg8::gemm_phase(lds, c.wv, g, S, E); }
            else { const int* be = (const int*)(c.ws + WS_TAB + TAB_BLKEXP); const int n_used = __builtin_amdgcn_readfirstlane(be[72]);
                pg8::Gemm g{(const bf16*)(c.ws + WS_AG), DM, (const bf16*)(c.ws + WS_W13E), DM}; pg8::Order S; S.init(n_used, 2 * DFF / 256, c.G, bx, DM, be, (size_t)56 * MiB, false, 1); pg8::EpiSwigluT<true> E{(void*)(c.ws + WS_H), nullptr, 1.0f / (F8_A_SCALE * (float)(1 << F8_W13_EXP))}; pg8::gemm_phase<pg8::EpiSwigluT<true>, true, true, 1>(lds, c.wv, g, S, E); }
        }
        }
        SEAM(P + 11);
        for (int rep3 = 0; rep3 < ((l == 1) ? NREP(10) : 1); ++rep3) { if (rep3) GRID_BAR();
        if (IN(P + 12)) {
            if (l == 0) { pg8::Gemm g{(const bf16*)(c.ws + WS_H), DFF, (const bf16*)(c.ws + WS_W2D), DFF}; pg8::Order S; S.init(T / 256, DM / 256, c.G, bx, DFF); pg8::EpiRes<false> E{(bf16*)(c.ws + WS_XA), (const void*)x1, args.in[1] + DM, hn, (float*)(c.ws + WS_SSP + MiB)}; pg8::gemm_phase(lds, c.wv, g, S, E); }
            else { const int* be = (const int*)(c.ws + WS_TAB + TAB_BLKEXP); const int n_used = __builtin_amdgcn_readfirstlane(be[72]);
                pg8::Gemm g{(const bf16*)(c.ws + WS_H), DFF, (const bf16*)(c.ws + WS_W2E), DFF}; pg8::Order S; S.init(n_used, DM / 256, c.G, bx, DFF, be, (size_t)28 * MiB, true, 1);
                pg8::EpiMoeDown E{(bf16*)(c.ws + WS_Y0), (bf16*)(c.ws + WS_YT), (const float*)(c.ws + WS_TAB + TAB_SLOTGATE), S.ks, 1.0f / (F8_H_SCALE * (float)(1 << F8_W2_EXP))}; pg8::gemm_phase<pg8::EpiMoeDown, true, true, 1>(lds, c.wv, g, S, E); }
        }
        }
        }
        if (l == 0) SEAM(P + 12);
    }
    SEAM(26);
    if (IN(27)) moe_combine_phase(c, (const bf16*)(c.ws + WS_XA), args.out);
}

extern "C" void kernel_launch(void* const* d_in, const int* in_sizes, int n_in, void* d_out, int out_size, void* d_ws, size_t ws_size, hipStream_t stream) {
    static int grid = 0;
    if (grid == 0) {
        if (n_in != 28 || out_size != T * DM || ws_size < WS_END2) { fprintf(stderr, "kernel_launch: unexpected shapes (n_in %d out %d ws %zu need %zu)\n", n_in, out_size, ws_size, (size_t)WS_END2); grid = -1; return; }
        int dev = 0, cus = 0, per_cu = 0;
        if (hipGetDevice(&dev) != hipSuccess || hipDeviceGetAttribute(&cus, hipDeviceAttributeMultiprocessorCount, dev) != hipSuccess) { grid = -1; return; }
        if (hipFuncSetAttribute((const void*)fwd_kernel, hipFuncAttributeMaxDynamicSharedMemorySize, LDS_BYTES) != hipSuccess) { fprintf(stderr, "kernel_launch: hipFuncSetAttribute failed\n"); grid = -1; return; }
        if (hipOccupancyMaxActiveBlocksPerMultiprocessor(&per_cu, (const void*)fwd_kernel, 512, LDS_BYTES) != hipSuccess || per_cu < 1) fprintf(stderr, "kernel_launch: occupancy query reports %d\n", per_cu);
        grid = cus;
    }
    if (grid < 0) return;
    Args a; memset(&a, 0, sizeof(a));
    for (int i = 0; i < 28; ++i) a.in[i] = (const float*)d_in[i];
    a.out = (float*)d_out; a.ws = (unsigned char*)d_ws;
    unsigned char* ws = (unsigned char*)d_ws;
    int nm = 0, item = 0;
    auto add = [&](const float* src, size_t dst_off, int K, int N, int mode, int ldd = 0, const float* gain = nullptr) { MatDesc& m = a.mat[nm++]; m.src = src; m.dst = (bf16*)(ws + dst_off); m.gain = gain; m.K = K; m.N = N; m.mode = mode; m.item0 = item; m.ldd = ldd ? ldd : K; m.pad = 0; item += (K / 64) * ((N + 31) / 32); };
    for (int l = 0; l < 2; ++l) {
        const size_t wl = WS_WL + l * WL_STRIDE;
        add(a.in[2] + (size_t)l * DM * DIN, wl + WL_IN, DM, DIN, 1);
        add(a.in[7] + (size_t)l * 4096 * 128, wl + WL_CK, 4096, 128, 0);
        add(a.in[8] + (size_t)l * 4096 * 128, wl + WL_CV, 4096, 128, 0);
        add(a.in[10] + (size_t)l * QLORA * 1536, wl + WL_QB, QLORA, 1536, 4, 0, a.in[9] + (size_t)l * QLORA);
        add(a.in[12] + (size_t)l * KVLORA * 2048, wl + WL_KVB, KVLORA, 2048, 0, 0, a.in[11] + (size_t)l * KVLORA);
        add(a.in[17] + (size_t)l * 1024 * DM, wl + WL_PA, 1024, DM, 0, 2048);
        add(a.in[18] + (size_t)l * 1024 * DM, wl + WL_PA + 2048, 1024, DM, 0, 2048);
        add(a.in[19] + (size_t)l * DM * DM, wl + WL_OUT, DM, DM, 0);
    }
    add(a.in[21], WS_W13D, DM, DFF, 2); add(a.in[22], WS_W13D, DM, DFF, 3); add(a.in[23], WS_W2D, DFF, DM, 0);
    for (int e = 0; e < NE; ++e) {
        add(a.in[25] + (size_t)e * DM * DFF, WS_W13E + (size_t)e * 56 * MiB, DM, DFF, 2); a.mat[nm - 1].pad = F8_W13_EXP;
        add(a.in[26] + (size_t)e * DM * DFF, WS_W13E + (size_t)e * 56 * MiB, DM, DFF, 3); a.mat[nm - 1].pad = F8_W13_EXP;
        add(a.in[27] + (size_t)e * DFF * DM, WS_W2E + (size_t)e * 28 * MiB, DFF, DM, 0); a.mat[nm - 1].pad = F8_W2_EXP;
    }
    a.total_items = item;
    a.bg_item0 = a.mat[5].item0;
    { const int nch = (item - a.bg_item0 + 127) / 128; const int need0 = (a.mat[19].item0 - a.bg_item0 + 127) / 128;
      int n0 = nch / 2; if (n0 < need0) n0 = need0; a.nch0 = n0; a.nch_total = nch; }
    if (hipMemsetAsync(ws + WS_CTL, 0, CTL_BYTES, stream) != hipSuccess) { fprintf(stderr, "kernel_launch: memset failed\n"); return; }
#if MK_ONE_LAUNCH
    a.ph_lo = 0; a.ph_hi = NPH;
    hipLaunchKernelGGL(fwd_kernel, dim3(grid), dim3(512), LDS_BYTES, stream, a);
#else
    for (int p = 0; p < NPH; ++p) { if (p == 11) continue; a.ph_lo = p; a.ph_hi = p + 1; hipLaunchKernelGGL(fwd_kernel, dim3(grid), dim3(512), LDS_BYTES, stream, a); }
#endif
    hipError_t le = hipGetLastError(); if (le != hipSuccess) fprintf(stderr, "kernel_launch: launch failed: %s\n", hipGetErrorName(le));
}
```

```cpp
#include <hip/hip_runtime.h>
#include <cstdio>
#include <cstdint>
#include <cstring>

#ifndef REPEAT_MASK
#define REPEAT_MASK 0
#endif
#define NREP(bit) (1 + ((REPEAT_MASK >> (bit)) & 1))
#ifndef MK_ONE_LAUNCH
#define MK_ONE_LAUNCH 1
#endif

#define GAS __attribute__((address_space(1)))
#define LAS __attribute__((address_space(3)))
typedef unsigned short bf16;
typedef short bf16x8 __attribute__((ext_vector_type(8)));
typedef short s16x4 __attribute__((ext_vector_type(4)));
typedef float f32x4 __attribute__((ext_vector_type(4)));
typedef float f32x16 __attribute__((ext_vector_type(16)));
typedef unsigned u32x4 __attribute__((ext_vector_type(4)));
typedef unsigned u32x2 __attribute__((ext_vector_type(2)));
typedef unsigned long long u64;

constexpr int BATCH = 2, SEQ = 4096, T = BATCH * SEQ, DM = 2048;
constexpr int HD = 128, NH = 8, NG = 2;
constexpr int QLORA = 768, KVLORA = 512, MH = 8;
constexpr int DFF = 7168, NE = 8;
constexpr int DIN = 8024, DINP = 8192;
constexpr int ZQ = 0, ZKV = 1024, ZQA = 2560, ZKVA = 3328, ZKR = 3840, ZG = 3904, ZM = 4096;
constexpr float EPS = 1e-6f;
constexpr int NSLOT_MAX = 72 * 256;
constexpr int NPH = 28;

constexpr size_t MiB = 1u << 20;
constexpr size_t WS_CTL = 0, CTL_BYTES = 1 * MiB;
constexpr size_t WS_TAB = 1 * MiB;
constexpr size_t TAB_COS_TOK = 0, TAB_SIN_TOK = 256 * 1024, TAB_COS_MLA = 512 * 1024, TAB_SIN_MLA = 1024 * 1024,
                 TAB_COS_CMP = 1536 * 1024, TAB_SIN_CMP = 1536 * 1024 + 16384, TAB_ORDER = 1536 * 1024 + 32768, TAB_ROUTE = 2 * MiB  ,
                 TAB_SLOTTOK = 2 * MiB + 128 * 1024  , TAB_SLOTGATE = 2 * MiB + 256 * 1024, TAB_BLKEXP = 2 * MiB + 384 * 1024  ,
                 TAB_SELMASK = 2 * MiB + 512 * 1024  , TAB_TOKSLOT = 2 * MiB + 640 * 1024  ;
constexpr size_t WS_WL = 4 * MiB;
constexpr size_t WL_STRIDE = 56 * MiB;
constexpr size_t WL_IN = 0, WL_QB = 32 * MiB, WL_KVB = 35 * MiB, WL_CK = 37 * MiB, WL_CV = 38 * MiB, WL_PA = 39 * MiB, WL_PB = 43 * MiB, WL_OUT = 47 * MiB;
constexpr size_t WS_W13D = WS_WL + 2 * WL_STRIDE;
constexpr size_t WS_W2D = WS_W13D + 56 * MiB;
constexpr size_t WS_W13E = WS_W2D + 28 * MiB;
constexpr size_t WS_W2E = WS_W13E + 448 * MiB;
constexpr size_t WS_ZA = WS_W2E + 224 * MiB;
constexpr size_t WS_H = WS_ZA;
constexpr size_t WS_Z = WS_ZA;
constexpr size_t WS_QRAW = WS_ZA + 128 * MiB;
constexpr size_t WS_KVRAW = WS_QRAW + 24 * MiB;
constexpr size_t WS_QM = WS_KVRAW + 32 * MiB;
constexpr size_t WS_KM = WS_QM + 24 * MiB;
constexpr size_t WS_VM = WS_KM + 16 * MiB;
constexpr size_t WS_ZB = WS_ZA + 252 * MiB;
constexpr size_t WS_HN = WS_ZB;
constexpr size_t WS_AG = WS_HN + 32 * MiB;
constexpr size_t WS_X1 = WS_AG + 72 * MiB;
constexpr size_t WS_XA = WS_X1 + 64 * MiB;
constexpr size_t WS_MIX1 = WS_XA + 64 * MiB;
constexpr size_t WS_MIX = WS_MIX1 + 64 * MiB;
constexpr size_t WS_QN = WS_MIX + 32 * MiB;
constexpr size_t WS_NSAKV = WS_QN + 16 * MiB;
constexpr size_t NSAKV_ONE = (size_t)BATCH * NG * SEQ * HD * 2;
constexpr size_t WS_QAN = WS_NSAKV + 24 * MiB;
constexpr size_t WS_KVAN = WS_QAN + 12 * MiB;
constexpr size_t WS_KR = WS_KVAN + 8 * MiB;
constexpr size_t WS_GNSA = WS_KR + 1 * MiB;
constexpr size_t WS_KC = WS_GNSA + 1 * MiB;
constexpr size_t WS_VC = WS_KC + 512 * 1024;
constexpr size_t WS_OC = WS_KC + 1 * MiB;
constexpr size_t WS_OS = WS_OC + 16 * MiB, WS_OW = WS_OS + 16 * MiB;
constexpr size_t WS_OA = WS_OW + 16 * MiB, WS_OB = WS_OA + 16 * MiB;
constexpr size_t WS_END = WS_OB + 16 * MiB;
constexpr size_t WS_SSP = WS_END;
constexpr size_t WS_SSQ = WS_SSP + 2 * MiB;
constexpr size_t WS_SSKV = WS_SSQ + 512 * 1024;
constexpr size_t WS_END2 = WS_SSQ + 1 * MiB;
constexpr size_t WS_Y0 = WS_HN;
constexpr size_t WS_YT = WS_MIX1;
static_assert(WS_Y0 + (size_t)NSLOT_MAX * DM * 4 <= WS_XA, "Y0 overlay");

constexpr int CW_BAR = 4096;
constexpr int CW_QUEUE = 16384;
constexpr int CW_P3 = 57344;
constexpr int CW_UNIT = 49152;
constexpr int CW_PANEL = 32768;
constexpr int CW_SS = 32768;
#ifndef CONV_LIMIT
#define CONV_LIMIT 128
#endif

constexpr int RING_BYTES = 131072, MISC_OFF = RING_BYTES + 320, LDS_BYTES = 147456;

__device__ __forceinline__ unsigned cvt_pk_bf16(float lo, float hi) { unsigned r; asm volatile("v_cvt_pk_bf16_f32 %0, %1, %2" : "=v"(r) : "v"(lo), "v"(hi)); return r; }
__device__ __forceinline__ float bf2f(unsigned short b) { return __uint_as_float(((unsigned)b) << 16); }
__device__ __forceinline__ float bflo(unsigned w) { return __uint_as_float(w << 16); }
__device__ __forceinline__ float bfhi(unsigned w) { return __uint_as_float(w & 0xffff0000u); }
__device__ __forceinline__ int lane_id_fresh() { int l; asm volatile("v_mbcnt_lo_u32_b32 %0, -1, 0\n\tv_mbcnt_hi_u32_b32 %0, -1, %0" : "=v"(l)); return l; }
__device__ __forceinline__ int fresh_tid(int wv) { return (wv << 6) | lane_id_fresh(); }
template <class T> __device__ __forceinline__ T shx(T v, int m) { static_assert(sizeof(T) == 4, "32-bit only"); return __builtin_bit_cast(T, __builtin_amdgcn_ds_bpermute((lane_id_fresh() ^ m) << 2, __builtin_bit_cast(int, v))); }
__device__ __forceinline__ float wave_sum(float v) {
#pragma unroll
    for (int o = 1; o < 64; o <<= 1) v += shx(v, o);
    return v;
}
__device__ __forceinline__ float fexp2(float x) { return __builtin_amdgcn_exp2f(x); }
__device__ __forceinline__ float fma_s(float a, float b, float c) { float r; asm("v_fma_f32 %0, %1, %2, %3" : "=v"(r) : "v"(a), "v"(b), "v"(c)); return r; }
__device__ __forceinline__ void pair32(float x, float& a, float& b) { a = x; b = x; asm volatile("s_nop 1\n\tv_permlane32_swap_b32 %0, %1" : "+v"(a), "+v"(b)); }
__device__ __forceinline__ float sum4x(float x) { float a = x, b = x; asm volatile("s_nop 1\n\tv_permlane16_swap_b32 %0, %1" : "+v"(a), "+v"(b)); x = a + b; a = x; b = x; asm volatile("s_nop 1\n\tv_permlane32_swap_b32 %0, %1" : "+v"(a), "+v"(b)); return a + b; }
__device__ __forceinline__ float add_s(float a, float b) { float r; asm("v_add_f32 %0, %1, %2" : "=v"(r) : "v"(a), "v"(b)); return r; }
__device__ __forceinline__ float frcp(float x) { return __builtin_amdgcn_rcpf(x); }
__device__ __forceinline__ float sigmoidf_(float x) { return frcp(1.0f + fexp2(-1.4426950408889634f * x)); }
__device__ __forceinline__ void unpack8(u32x4 w, float (&v)[8]) { v[0] = bflo(w.x); v[1] = bfhi(w.x); v[2] = bflo(w.y); v[3] = bfhi(w.y); v[4] = bflo(w.z); v[5] = bfhi(w.z); v[6] = bflo(w.w); v[7] = bfhi(w.w); }
__device__ __forceinline__ u32x4 pack8f(const float* v) { u32x4 w; w.x = cvt_pk_bf16(v[0], v[1]); w.y = cvt_pk_bf16(v[2], v[3]); w.z = cvt_pk_bf16(v[4], v[5]); w.w = cvt_pk_bf16(v[6], v[7]); return w; }

typedef int v4i_t __attribute__((ext_vector_type(4)));
typedef int v8i_t __attribute__((ext_vector_type(8)));
__device__ __forceinline__ float f8_clamp(float v) { return __builtin_fminf(__builtin_fmaxf(v, -448.f), 448.f); }
__device__ __forceinline__ unsigned pk4_f8(float a, float b, float c, float d) { int w = __builtin_amdgcn_cvt_pk_fp8_f32(f8_clamp(a), f8_clamp(b), 0, false); w = __builtin_amdgcn_cvt_pk_fp8_f32(f8_clamp(c), f8_clamp(d), w, true); return (unsigned)w; }
__device__ __forceinline__ void rope_cs(float pos, int k, float kscale, float& c, float& sn) {
    const float inv = __builtin_amdgcn_exp2f(-(float)k * kscale), rev = pos * inv * 0.15915494309189535f, fr = __builtin_amdgcn_fractf(rev);
    c = __builtin_amdgcn_cosf(fr); sn = __builtin_amdgcn_sinf(fr); }
constexpr float ROPE_L2T = 18.931568569324174f;
constexpr int F8_W13_EXP = 11, F8_W2_EXP = 12;
constexpr float F8_A_SCALE = 16.f, F8_H_SCALE = 8.f;
namespace pg8 {
constexpr int BM = 256, BK = 64, HALF = 128, HTB = HALF * BK * 2, STAGE_BYTES = 8 * HTB, NXCD = 8, WGM = 8;
__host__ __device__ __forceinline__ int lds_byte(int r, int c) { const int st = (r >> 4) * 2 + (c >> 5), rr = r & 15, cc = c & 31, ob = rr * 64 + cc * 2; return st * 1024 + (ob ^ (((ob >> 9) & 1) << 5)); }
__host__ __device__ __forceinline__ void stage_rc(int b, int& R, int& C) { const int st = b / 1024, sb = b % 1024, swz = sb ^ (((sb >> 9) & 1) << 5); R = (st >> 1) * 16 + swz / 64; C = (st & 1) * 32 + (swz % 64) / 2; }
__host__ __device__ __forceinline__ int perm32(int rho) { const int n = rho >> 4, i = rho & 15; return 8 * (i >> 2) + 4 * n + (i & 3); }

template <int ES> struct Frag;
template <> struct Frag<2> { bf16x8 k[2]; };
template <> struct Frag<1> { v8i_t v; };
struct Unit { int pm, pn, kofs, nt, kidx, tail; };
struct Gemm { const bf16* A; int lda; const bf16* Bt; int K; };

struct Order {
    int nM, nN, nwg, G, c; const int* blk_exp; size_t estride; int nt_full, n_full, ks, es, rot;
    static __device__ __forceinline__ void tail_params(int nwg, int G, int nt_full, int& n_full, int& ks) {
        n_full = nwg; ks = 1;
        const int nf = (nwg / G) * G, r = nwg - nf; if (r > 0) { int s = G / r; s = s > 4 ? 4 : s; while (s > 1 && (nt_full % (2 * s)) != 0) --s; if (s > 1) { n_full = nf; ks = s; } } }
    __device__ __forceinline__ void init(int nM_, int nN_, int G_, int c_, int K, const int* be = nullptr, size_t estr = 0, bool tail_split = false, int es_ = 2) { nM = nM_; nN = nN_; nwg = nM * nN; G = G_; c = c_; blk_exp = be; estride = estr; es = es_; rot = 0;
        nt_full = K * es_ / 128; n_full = nwg; ks = 1;
        if (tail_split) tail_params(nwg, G, nt_full, n_full, ks); }
    static __device__ __forceinline__ int tile_wgid(int nM, int nN, int pm, int pn) { const int gid = pm / WGM, fm = gid * WGM, gsz = (nM - fm) < WGM ? (nM - fm) : WGM; return gid * (WGM * nN) + pn * gsz + (pm - fm); }
    __device__ __forceinline__ bool next(int i, Unit& u) const {
        const long L = (long)i * G + c; int wgid; u.kofs = 0; u.nt = nt_full; u.kidx = 0; u.tail = 0;
        if (L < n_full) { wgid = (int)L; const int q = n_full / NXCD, r = n_full % NXCD, xcd = wgid % NXCD, off = wgid / NXCD; wgid = (xcd < r ? xcd * (q + 1) : r * (q + 1) + (xcd - r) * q) + off; }
        else { const long Ls = L - n_full; const long ui = n_full + Ls / ks; if (ui >= nwg) return false; wgid = (int)ui; u.nt = nt_full / ks; u.kidx = (int)(Ls % ks); u.kofs = u.kidx * u.nt; u.tail = wgid - n_full; }
        const int nig = WGM * nN, gid = wgid / nig, fm = gid * WGM, gsz = (nM - fm) < WGM ? (nM - fm) : WGM;
        u.pm = fm + ((wgid % nig) % gsz); u.pn = (wgid % nig) / gsz; if (rot && (i & 1)) { u.pn += nN >> 1; if (u.pn >= nN) u.pn -= nN; } return true;
    }
    __device__ __forceinline__ void ptrs(const Gemm& g, const Unit& u, const char*& a, const char*& b) const {
        a = (const char*)g.A + (size_t)u.pm * 256 * g.lda * es + (size_t)u.kofs * 128;
        b = (const char*)g.Bt + (size_t)u.pn * 256 * g.K * es + (size_t)u.kofs * 128 + (blk_exp ? (size_t)__builtin_amdgcn_readfirstlane(blk_exp[u.pm]) * estride : (size_t)0);
    }
};

template <int NP> __device__ __forceinline__ void row_rs8(const float* ssp, int row0, int fq, float (&rs)[2][4], float inv_n) {
    if (!ssp) {
#pragma unroll
        for (int ai = 0; ai < 2; ++ai)
#pragma unroll
            for (int m = 0; m < 4; ++m) rs[ai][m] = 1.0f;
        return; }
    constexpr int PER = NP / 4;
    float a[2][4][PER];
#pragma unroll
    for (int ai = 0; ai < 2; ++ai)
#pragma unroll
        for (int m = 0; m < 4; ++m) { const float* p = ssp + (size_t)(row0 + ai * 128 + m * 16) * NP + fq * PER;
#pragma unroll
            for (int i = 0; i < PER; ++i) a[ai][m][i] = p[i]; }
#pragma unroll
    for (int ai = 0; ai < 2; ++ai)
#pragma unroll
        for (int m = 0; m < 4; ++m) { float s = a[ai][m][0];
#pragma unroll
            for (int i = 1; i < PER; ++i) s += a[ai][m][i];
            s = sum4x(s); rs[ai][m] = __builtin_amdgcn_rsqf(s * inv_n + EPS); }
}
template <int NP> struct EpiBf16 {
    static constexpr bool PERM = true, MID = false;
    bf16* O; int ldc; const float* ss; float inv_n;
    __device__ __forceinline__ void operator()(const f32x4 (&acc)[2][2][4][2], const Unit& u, int wr, int wc, int fr, int fq) const {
        const int row0 = u.pm * BM + wr * 64 + fr, col0 = u.pn * BM + wc * 32 + 8 * fq;
        float rsv[2][4]; row_rs8<NP>(ss, row0, fq, rsv, inv_n);
#pragma unroll
        for (int ai = 0; ai < 2; ++ai)
#pragma unroll
            for (int m = 0; m < 4; ++m) { bf16* rowp = O + (size_t)(row0 + ai * HALF + m * 16) * ldc + col0;
                const float rs = rsv[ai][m];
#pragma unroll
                for (int bj = 0; bj < 2; ++bj) { const f32x4 v0 = acc[ai][bj][m][0] * rs, v1 = acc[ai][bj][m][1] * rs;
                    u32x4 w; w.x = cvt_pk_bf16(v0[0], v0[1]); w.y = cvt_pk_bf16(v0[2], v0[3]); w.z = cvt_pk_bf16(v1[0], v1[1]); w.w = cvt_pk_bf16(v1[2], v1[3]);
                    *(u32x4*)(rowp + bj * HALF) = w; } }
    }
};
struct EpiQb {
    static constexpr bool PERM = true, MID = false;
    bf16* Qm; const float* ss; const float* gn128; const float* gr64; const float* cosM; const float* sinM; LAS float* X;
    __device__ __forceinline__ void operator()(const f32x4 (&acc)[2][2][4][2], const Unit& u, int wr, int wc, int fr, int fq) const {
        int rl0 = wr * 64 + fr, colw = wc * 32 + 8 * fq; asm volatile("" : "+v"(rl0), "+v"(colw));
        const int row0 = u.pm * BM + rl0, pn = u.pn;
        float rsv[2][4]; row_rs8<12>(ss, row0, fq, rsv, 1.0f / QLORA);
#pragma unroll
        for (int ai = 0; ai < 2; ++ai)
#pragma unroll
            for (int m = 0; m < 4; ++m) { const float rs = rsv[ai][m];
#pragma unroll
                for (int bj = 0; bj < 2; ++bj) { const f32x4 v0 = acc[ai][bj][m][0] * rs, v1 = acc[ai][bj][m][1] * rs;
                    float sq = ((v0[0] * v0[0] + v0[1] * v0[1]) + (v0[2] * v0[2] + v0[3] * v0[3])) + ((v1[0] * v1[0] + v1[1] * v1[1]) + (v1[2] * v1[2] + v1[3] * v1[3]));
                    sq = sum4x(sq);
                    if (fq == 0) X[(bj * 256 + rl0 + ai * HALF + m * 16) * 4 + wc] = sq; } }
        asm volatile("s_waitcnt lgkmcnt(0)" ::: "memory"); __builtin_amdgcn_s_barrier(); asm volatile("" ::: "memory");
        const int b = (u.pm * BM) / SEQ;
        if (pn < 4) {
            const f32x4 g0 = *(const f32x4*)(gn128 + colw), g1 = *(const f32x4*)(gn128 + colw + 4);
#pragma unroll
            for (int ai = 0; ai < 2; ++ai)
#pragma unroll
                for (int m = 0; m < 4; ++m) { const int rl = rl0 + ai * HALF + m * 16, row = u.pm * BM + rl; const float rs = rsv[ai][m];
#pragma unroll
                    for (int bj = 0; bj < 2; ++bj) { const f32x4 t4 = *(const LAS f32x4*)(X + (bj * 256 + rl) * 4);
                        const float rn = __builtin_amdgcn_rsqf(((t4[0] + t4[1]) + (t4[2] + t4[3])) * (1.0f / 128.0f) + EPS);
                        const f32x4 y0 = acc[ai][bj][m][0] * (rs * rn) * g0, y1 = acc[ai][bj][m][1] * (rs * rn) * g1;
                        u32x4 w; w.x = cvt_pk_bf16(y0[0], y0[1]); w.y = cvt_pk_bf16(y0[2], y0[3]); w.z = cvt_pk_bf16(y1[0], y1[1]); w.w = cvt_pk_bf16(y1[2], y1[3]);
                        *(u32x4*)(Qm + ((size_t)row * 8 + 2 * pn + bj) * 192 + colw) = w; } asm volatile("" ::: "memory"); }
        } else {
            const int w2 = wc & 1, dimb = 16 * w2 + 8 * (fq & 1) + 32 * (fq >> 1), ib = 16 * w2 + 8 * (fq & 1);
            const f32x4 g0 = *(const f32x4*)(gr64 + dimb), g1 = *(const f32x4*)(gr64 + dimb + 4);
#pragma unroll
            for (int ai = 0; ai < 2; ++ai)
#pragma unroll
                for (int m = 0; m < 4; ++m) { const int rl = rl0 + ai * HALF + m * 16, row = u.pm * BM + rl, sp = row - b * SEQ; const float rs = rsv[ai][m];
                    const f32x4 c0 = *(const f32x4*)(cosM + sp * 32 + ib), c1 = *(const f32x4*)(cosM + sp * 32 + ib + 4), s0 = *(const f32x4*)(sinM + sp * 32 + ib), s1 = *(const f32x4*)(sinM + sp * 32 + ib + 4);
#pragma unroll
                    for (int bj = 0; bj < 2; ++bj) { const LAS float* xp = X + (bj * 256 + rl) * 4 + (wc & 2);
                        const float rn = __builtin_amdgcn_rsqf((xp[0] + xp[1]) * (1.0f / 64.0f) + EPS);
                        f32x4 y0 = acc[ai][bj][m][0] * (rs * rn) * g0, y1 = acc[ai][bj][m][1] * (rs * rn) * g1, p0, p1;
#pragma unroll
                        for (int e = 0; e < 4; ++e) { p0[e] = shx(y0[e], 32); p1[e] = shx(y1[e], 32); }
                        if (fq < 2) { y0 = y0 * c0 - p0 * s0; y1 = y1 * c1 - p1 * s1; } else { y0 = y0 * c0 + p0 * s0; y1 = y1 * c1 + p1 * s1; }
                        u32x4 w; w.x = cvt_pk_bf16(y0[0], y0[1]); w.y = cvt_pk_bf16(y0[2], y0[3]); w.z = cvt_pk_bf16(y1[0], y1[1]); w.w = cvt_pk_bf16(y1[2], y1[3]);
                        const int head = 4 * (pn - 4) + 2 * bj + (wc >> 1);
                        *(u32x4*)(Qm + ((size_t)row * 8 + head) * 192 + 128 + dimb) = w; } asm volatile("" ::: "memory"); }
        }
    }
};
struct EpiKvb {
    static constexpr bool PERM = true, MID = false;
    bf16* Km; bf16* Vm; const float* ss; const float* gk; LAS float* X;
    __device__ __forceinline__ void operator()(const f32x4 (&acc)[2][2][4][2], const Unit& u, int wr, int wc, int fr, int fq) const {
        int rl0 = wr * 64 + fr, colw = wc * 32 + 8 * fq; asm volatile("" : "+v"(rl0), "+v"(colw));
        const int row0 = u.pm * BM + rl0;
        float rsv[2][4]; row_rs8<8>(ss, row0, fq, rsv, 1.0f / KVLORA);
#pragma unroll
        for (int ai = 0; ai < 2; ++ai)
#pragma unroll
            for (int m = 0; m < 4; ++m) { const float rs = rsv[ai][m]; const f32x4 v0 = acc[ai][0][m][0] * rs, v1 = acc[ai][0][m][1] * rs;
                float sq = ((v0[0] * v0[0] + v0[1] * v0[1]) + (v0[2] * v0[2] + v0[3] * v0[3])) + ((v1[0] * v1[0] + v1[1] * v1[1]) + (v1[2] * v1[2] + v1[3] * v1[3]));
                sq = sum4x(sq);
                if (fq == 0) X[(rl0 + ai * HALF + m * 16) * 4 + wc] = sq; }
        asm volatile("s_waitcnt lgkmcnt(0)" ::: "memory"); __builtin_amdgcn_s_barrier(); asm volatile("" ::: "memory");
        const int b = (u.pm * BM) / SEQ;
        const f32x4 g0 = *(const f32x4*)(gk + colw), g1 = *(const f32x4*)(gk + colw + 4);
#pragma unroll
        for (int ai = 0; ai < 2; ++ai)
#pragma unroll
            for (int m = 0; m < 4; ++m) { const int rl = rl0 + ai * HALF + m * 16, row = u.pm * BM + rl, sp = row - b * SEQ; const float rs = rsv[ai][m];
                const f32x4 t4 = *(const LAS f32x4*)(X + rl * 4); const float rn = __builtin_amdgcn_rsqf(((t4[0] + t4[1]) + (t4[2] + t4[3])) * (1.0f / 128.0f) + EPS);
                const size_t hm = (((size_t)b * 8 + u.pn) * SEQ + sp) * 128 + colw;
                { const f32x4 y0 = acc[ai][0][m][0] * (rs * rn) * g0, y1 = acc[ai][0][m][1] * (rs * rn) * g1;
                  u32x4 w; w.x = cvt_pk_bf16(y0[0], y0[1]); w.y = cvt_pk_bf16(y0[2], y0[3]); w.z = cvt_pk_bf16(y1[0], y1[1]); w.w = cvt_pk_bf16(y1[2], y1[3]); *(u32x4*)(Km + hm) = w; }
                { const f32x4 y0 = acc[ai][1][m][0] * rs, y1 = acc[ai][1][m][1] * rs;
                  u32x4 w; w.x = cvt_pk_bf16(y0[0], y0[1]); w.y = cvt_pk_bf16(y0[2], y0[3]); w.z = cvt_pk_bf16(y1[0], y1[1]); w.w = cvt_pk_bf16(y1[2], y1[3]); *(u32x4*)(Vm + hm) = w; } asm volatile("" ::: "memory"); }
    }
};
struct EpiInProj {
    static constexpr bool PERM = true, MID = false;
    bf16* Z; const float* ssin; bf16* Qn; unsigned char* nsakv; float* ssq; float* sskv; const float* qg; const float* kg; const float* cosT; const float* sinT; LAS float* X;
    bf16* Kr; float* gn; const float* krg; const float* cosM; const float* sinM;
    __device__ __forceinline__ void operator()(const f32x4 (&acc)[2][2][4][2], const Unit& u, int wr, int wc, int fr, int fq) const {
        int rl0 = wr * 64 + fr, colw = wc * 32 + 8 * fq; asm volatile("" : "+v"(rl0), "+v"(colw));
        const int row0 = u.pm * BM + rl0, pn = u.pn;
        float rsv[2][4]; row_rs8<32>(ssin, row0, fq, rsv, 1.0f / DM);
        if (pn == 15) {
            if (wc < 2) {
#pragma unroll
                for (int ai = 0; ai < 2; ++ai)
#pragma unroll
                    for (int m = 0; m < 4; ++m) { const float rs = rsv[ai][m]; const f32x4 v0 = acc[ai][0][m][0] * rs, v1 = acc[ai][0][m][1] * rs;
                        float sq = ((v0[0] * v0[0] + v0[1] * v0[1]) + (v0[2] * v0[2] + v0[3] * v0[3])) + ((v1[0] * v1[0] + v1[1] * v1[1]) + (v1[2] * v1[2] + v1[3] * v1[3]));
                        sq = sum4x(sq);
                        if (fq == 0) X[(rl0 + ai * HALF + m * 16) * 4 + wc] = sq; } }
            asm volatile("s_waitcnt lgkmcnt(0)" ::: "memory"); __builtin_amdgcn_s_barrier(); asm volatile("" ::: "memory");
            const int b15 = (u.pm * BM) / SEQ;
            if (wc < 2) { const int dimb = 16 * wc + 8 * (fq & 1) + 32 * (fq >> 1), ib = 16 * wc + 8 * (fq & 1);
                const f32x4 g0 = *(const f32x4*)(krg + dimb), g1 = *(const f32x4*)(krg + dimb + 4);
#pragma unroll
                for (int ai = 0; ai < 2; ++ai)
#pragma unroll
                    for (int m = 0; m < 4; ++m) { const int rl = rl0 + ai * HALF + m * 16, row = u.pm * BM + rl, sp = row - b15 * SEQ; const float rs = rsv[ai][m];
                        const float rn = __builtin_amdgcn_rsqf((X[rl * 4] + X[rl * 4 + 1]) * (1.0f / 64.0f) + EPS);
                        f32x4 c0, c1, s0, s1; { const float fp = (float)sp;
#pragma unroll
                            for (int e = 0; e < 4; ++e) { float ca, sa, cb, sb; rope_cs(fp, ib + e, ROPE_L2T / 32.0f, ca, sa); rope_cs(fp, ib + 4 + e, ROPE_L2T / 32.0f, cb, sb); c0[e] = ca; s0[e] = sa; c1[e] = cb; s1[e] = sb; } }
                        f32x4 y0 = acc[ai][0][m][0] * (rs * rn) * g0, y1 = acc[ai][0][m][1] * (rs * rn) * g1, p0, p1;
#pragma unroll
                        for (int e = 0; e < 4; ++e) { p0[e] = shx(y0[e], 32); p1[e] = shx(y1[e], 32); }
                        if (fq < 2) { y0 = y0 * c0 - p0 * s0; y1 = y1 * c1 - p1 * s1; } else { y0 = y0 * c0 + p0 * s0; y1 = y1 * c1 + p1 * s1; }
                        u32x4 w; w.x = cvt_pk_bf16(y0[0], y0[1]); w.y = cvt_pk_bf16(y0[2], y0[3]); w.z = cvt_pk_bf16(y1[0], y1[1]); w.w = cvt_pk_bf16(y1[2], y1[3]);
                        *(u32x4*)(Kr + (size_t)row * 64 + dimb) = w; asm volatile("" ::: "memory"); } }
            else if (wc == 2 && fq < 3) {
#pragma unroll
                for (int ai = 0; ai < 2; ++ai)
#pragma unroll
                    for (int m = 0; m < 4; ++m) { const int row = row0 + ai * HALF + m * 16; const float rs = rsv[ai][m]; f32x4 o0, o1;
#pragma unroll
                        for (int e = 0; e < 4; ++e) { o0[e] = sigmoidf_(acc[ai][0][m][0][e] * rs); o1[e] = sigmoidf_(acc[ai][0][m][1][e] * rs); }
                        float* gp = gn + (size_t)row * 24 + 8 * fq; *(f32x4*)gp = o0; *(f32x4*)(gp + 4) = o1; } }
            return;
        }
        if (pn >= 10) {
#pragma unroll
            for (int ai = 0; ai < 2; ++ai)
#pragma unroll
                for (int m = 0; m < 4; ++m) { const int row = row0 + ai * HALF + m * 16; const float rs = rsv[ai][m]; float sq = 0.f;
#pragma unroll
                    for (int bj = 0; bj < 2; ++bj) { const f32x4 v0 = acc[ai][bj][m][0] * rs, v1 = acc[ai][bj][m][1] * rs;
                        u32x4 w; w.x = cvt_pk_bf16(v0[0], v0[1]); w.y = cvt_pk_bf16(v0[2], v0[3]); w.z = cvt_pk_bf16(v1[0], v1[1]); w.w = cvt_pk_bf16(v1[2], v1[3]);
                        *(u32x4*)(Z + (size_t)row * DINP + pn * BM + bj * HALF + colw) = w;
                        sq += ((v0[0] * v0[0] + v0[1] * v0[1]) + (v0[2] * v0[2] + v0[3] * v0[3])) + ((v1[0] * v1[0] + v1[1] * v1[1]) + (v1[2] * v1[2] + v1[3] * v1[3])); }
                    if (pn < 15) { sq = sum4x(sq);
                        if (fq == 0) { if (pn < 13) ssq[(size_t)row * 12 + (pn - 10) * 4 + wc] = sq; else sskv[(size_t)row * 8 + (pn - 13) * 4 + wc] = sq; } } }
            return;
        }
        const bool do_norm = (pn < 4) || (pn == 6) || (pn == 8);
        const float* gvec = (pn < 4) ? qg : kg + ((pn - 4) >> 1) * 128;
        if (do_norm) {
#pragma unroll
            for (int ai = 0; ai < 2; ++ai)
#pragma unroll
                for (int m = 0; m < 4; ++m) { const float rs = rsv[ai][m];
#pragma unroll
                    for (int bj = 0; bj < 2; ++bj) { const f32x4 v0 = acc[ai][bj][m][0] * rs, v1 = acc[ai][bj][m][1] * rs;
                        float sq = ((v0[0] * v0[0] + v0[1] * v0[1]) + (v0[2] * v0[2] + v0[3] * v0[3])) + ((v1[0] * v1[0] + v1[1] * v1[1]) + (v1[2] * v1[2] + v1[3] * v1[3]));
                        sq = sum4x(sq);
                        if (fq == 0) X[(bj * 256 + rl0 + ai * HALF + m * 16) * 4 + wc] = sq; } }
            asm volatile("s_waitcnt lgkmcnt(0)" ::: "memory"); __builtin_amdgcn_s_barrier(); asm volatile("" ::: "memory");
        }
        const int b = (u.pm * BM) / SEQ;
        f32x4 gv[2]; gv[0] = (f32x4){1.f, 1.f, 1.f, 1.f}; gv[1] = gv[0];
        if (do_norm) { gv[0] = *(const f32x4*)(gvec + colw); gv[1] = *(const f32x4*)(gvec + colw + 4); }
#pragma unroll
        for (int ai = 0; ai < 2; ++ai)
#pragma unroll
            for (int m = 0; m < 4; ++m) { const int rl = rl0 + ai * HALF + m * 16, row = u.pm * BM + rl, sp = row - b * SEQ; const float rs = rsv[ai][m];
                f32x4 c0 = (f32x4){1.f, 1.f, 1.f, 1.f}, c1 = c0, s0 = (f32x4){0.f, 0.f, 0.f, 0.f}, s1 = s0;
                if (do_norm && wc == 0) { const float fp = (float)sp; const int kb = 8 * (fq & 1);
#pragma unroll
                    for (int e = 0; e < 4; ++e) { float ca, sa, cb, sb; rope_cs(fp, kb + e, ROPE_L2T / 16.0f, ca, sa); rope_cs(fp, kb + 4 + e, ROPE_L2T / 16.0f, cb, sb); c0[e] = ca; s0[e] = sa; c1[e] = cb; s1[e] = sb; } }
#pragma unroll
                for (int bj = 0; bj < 2; ++bj) {
                    float rn = 1.0f;
                    if (do_norm) { const f32x4 t4 = *(const LAS f32x4*)(X + (bj * 256 + rl) * 4); rn = __builtin_amdgcn_rsqf(((t4[0] + t4[1]) + (t4[2] + t4[3])) * (1.0f / 128.0f) + EPS); }
                    f32x4 y0 = acc[ai][bj][m][0] * (rs * rn) * gv[0], y1 = acc[ai][bj][m][1] * (rs * rn) * gv[1];
                    if (do_norm && wc == 0) {
                        f32x4 p0, p1;
#pragma unroll
                        for (int e = 0; e < 4; ++e) { p0[e] = shx(y0[e], 32); p1[e] = shx(y1[e], 32); }
                        if (fq < 2) { y0 = y0 * c0 - p0 * s0; y1 = y1 * c1 - p1 * s1; } else { y0 = y0 * c0 + p0 * s0; y1 = y1 * c1 + p1 * s1; }
                    }
                    u32x4 w; w.x = cvt_pk_bf16(y0[0], y0[1]); w.y = cvt_pk_bf16(y0[2], y0[3]); w.z = cvt_pk_bf16(y1[0], y1[1]); w.w = cvt_pk_bf16(y1[2], y1[3]);
                    bf16* dst;
                    if (pn < 4) dst = Qn + (size_t)row * 1024 + (2 * pn + bj) * HD + colw;
                    else dst = (bf16*)(nsakv + (size_t)(pn - 4) * NSAKV_ONE) + ((size_t)(b * NG + bj) * SEQ + sp) * HD + colw;
                    *(u32x4*)dst = w; } asm volatile("" ::: "memory"); }
    }
};
struct EpiGateMix {
    static constexpr bool PERM = true, MID = true;
    bf16* O; const bf16* Z;
    __device__ __forceinline__ void mid(f32x4 (&acc)[2][2][4][2], const Unit& u, int wr, int wc, int fr, int fq) const {
        int row0 = u.pm * BM + wr * 64 + fr, col0 = u.pn * BM + wc * 32 + 8 * fq;
        asm volatile("" : "+v"(row0), "+v"(col0));
#pragma unroll
        for (int ai = 0; ai < 2; ++ai) {
            u32x4 zaw[4][2], zbw[4][2];
#pragma unroll
            for (int m = 0; m < 4; ++m)
#pragma unroll
                for (int bj = 0; bj < 2; ++bj) { const bf16* zp = Z + (size_t)(row0 + ai * HALF + m * 16) * DINP + ZM + col0 + bj * HALF; zaw[m][bj] = *(const u32x4*)zp; zbw[m][bj] = *(const u32x4*)(zp + DM); }
#pragma unroll
            for (int m = 0; m < 4; ++m)
#pragma unroll
                for (int bj = 0; bj < 2; ++bj) { float za[8], zb[8]; unpack8(zaw[m][bj], za); unpack8(zbw[m][bj], zb);
#pragma unroll
                    for (int e = 0; e < 4; ++e) {
                        acc[ai][bj][m][0][e] *= (1.0f + fexp2(-1.4426950408889634f * zb[e])) * frcp(1.0f + fexp2(-1.4426950408889634f * za[e]));
                        acc[ai][bj][m][1][e] *= (1.0f + fexp2(-1.4426950408889634f * zb[4 + e])) * frcp(1.0f + fexp2(-1.4426950408889634f * za[4 + e])); } }
            asm volatile("" ::: "memory"); }
    }
    __device__ __forceinline__ void operator()(const f32x4 (&acc)[2][2][4][2], const Unit& u, int wr, int wc, int fr, int fq) const {
        const int row0 = u.pm * BM + wr * 64 + fr, col0 = u.pn * BM + wc * 32 + 8 * fq;
#pragma unroll
        for (int ai = 0; ai < 2; ++ai) {
            u32x4 zw[4][2];
#pragma unroll
            for (int m = 0; m < 4; ++m)
#pragma unroll
                for (int bj = 0; bj < 2; ++bj) zw[m][bj] = *(const u32x4*)(Z + (size_t)(row0 + ai * HALF + m * 16) * DINP + ZM + DM + col0 + bj * HALF);
#pragma unroll
            for (int m = 0; m < 4; ++m)
#pragma unroll
                for (int bj = 0; bj < 2; ++bj) { float zf[8]; unpack8(zw[m][bj], zf);
                    const f32x4 v0 = acc[ai][bj][m][0], v1 = acc[ai][bj][m][1];
                    float o[8];
#pragma unroll
                    for (int e = 0; e < 4; ++e) { o[e] = sigmoidf_(zf[e]) * v0[e]; o[4 + e] = sigmoidf_(zf[4 + e]) * v1[e]; }
                    *(u32x4*)(O + (size_t)(row0 + ai * HALF + m * 16) * DM + col0 + bj * HALF) = pack8f(o); }
            asm volatile("" ::: "memory"); }
    }
};
template <bool RF32> struct EpiRes {
    static constexpr bool PERM = true, MID = false;
    bf16* O; const void* R; const float* gvec; bf16* hout; float* ss;
    __device__ __forceinline__ void operator()(const f32x4 (&acc)[2][2][4][2], const Unit& u, int wr, int wc, int fr, int fq) const {
        const int row0 = u.pm * BM + wr * 64 + fr, col0 = u.pn * BM + wc * 32 + 8 * fq;
        f32x4 gv[2][2];
        if (hout) {
#pragma unroll
            for (int bj = 0; bj < 2; ++bj)
#pragma unroll
                for (int n = 0; n < 2; ++n) gv[bj][n] = *(const f32x4*)(gvec + col0 + bj * HALF + 4 * n); }
#pragma unroll
        for (int ai = 0; ai < 2; ++ai) {
            f32x4 r[4][2][2];
#pragma unroll
            for (int m = 0; m < 4; ++m) { const size_t off = (size_t)(row0 + ai * HALF + m * 16) * DM + col0;
#pragma unroll
                for (int bj = 0; bj < 2; ++bj) {
                    if (RF32) { r[m][bj][0] = *(const f32x4*)((const float*)R + off + bj * HALF); r[m][bj][1] = *(const f32x4*)((const float*)R + off + bj * HALF + 4); }
                    else { const u32x4 w = *(const u32x4*)((const bf16*)R + off + bj * HALF); r[m][bj][0] = (f32x4){bflo(w.x), bfhi(w.x), bflo(w.y), bfhi(w.y)}; r[m][bj][1] = (f32x4){bflo(w.z), bfhi(w.z), bflo(w.w), bfhi(w.w)}; } } }
            asm volatile("" ::: "memory");
#pragma unroll
            for (int m = 0; m < 4; ++m) { const size_t off = (size_t)(row0 + ai * HALF + m * 16) * DM + col0; float sq = 0.f;
#pragma unroll
                for (int bj = 0; bj < 2; ++bj) { const f32x4 v0 = r[m][bj][0] + acc[ai][bj][m][0], v1 = r[m][bj][1] + acc[ai][bj][m][1];
                    u32x4 w; w.x = cvt_pk_bf16(v0[0], v0[1]); w.y = cvt_pk_bf16(v0[2], v0[3]); w.z = cvt_pk_bf16(v1[0], v1[1]); w.w = cvt_pk_bf16(v1[2], v1[3]);
                    *(u32x4*)(O + off + bj * HALF) = w;
                    if (hout) { const f32x4 h0 = v0 * gv[bj][0], h1 = v1 * gv[bj][1]; u32x4 hw; hw.x = cvt_pk_bf16(h0[0], h0[1]); hw.y = cvt_pk_bf16(h0[2], h0[3]); hw.z = cvt_pk_bf16(h1[0], h1[1]); hw.w = cvt_pk_bf16(h1[2], h1[3]);
                        *(u32x4*)(hout + off + bj * HALF) = hw;
                        sq += ((v0[0] * v0[0] + v0[1] * v0[1]) + (v0[2] * v0[2] + v0[3] * v0[3])) + ((v1[0] * v1[0] + v1[1] * v1[1]) + (v1[2] * v1[2] + v1[3] * v1[3])); } }
                if (hout) { sq = sum4x(sq); if (fq == 0) ss[(size_t)(row0 + ai * HALF + m * 16) * 32 + u.pn * 4 + wc] = sq; } }
            asm volatile("" ::: "memory");
        }
    }
};
template <bool F8> struct EpiSwigluT {
    static constexpr bool PERM = true, MID = false;
    void* O; const float* ss; float asc;
    __device__ __forceinline__ void operator()(const f32x4 (&acc)[2][2][4][2], const Unit& u, int wr, int wc, int fr, int fq) const {
        const int row0 = u.pm * BM + wr * 64 + fr, col0 = u.pn * HALF + wc * 32 + 8 * fq;
        float rsv[2][4]; row_rs8<32>(ss, row0, fq, rsv, 1.0f / DM);
#pragma unroll
        for (int ai = 0; ai < 2; ++ai)
#pragma unroll
            for (int m = 0; m < 4; ++m) { float o[8];
                const float rs = F8 ? rsv[ai][m] * asc : rsv[ai][m], rsb = F8 ? rs * F8_H_SCALE : rs;
#pragma unroll
                for (int n = 0; n < 2; ++n)
#pragma unroll
                    for (int e = 0; e < 4; ++e) { const float a = acc[ai][0][m][n][e] * rs, b = acc[ai][1][m][n][e] * rsb; o[4 * n + e] = a * sigmoidf_(a) * b; }
                if constexpr (F8) { u32x2 w; w.x = pk4_f8(o[0], o[1], o[2], o[3]); w.y = pk4_f8(o[4], o[5], o[6], o[7]); *(u32x2*)((unsigned char*)O + (size_t)(row0 + ai * HALF + m * 16) * DFF + col0) = w; }
                else *(u32x4*)((bf16*)O + (size_t)(row0 + ai * HALF + m * 16) * DFF + col0) = pack8f(o); }
    }
};
using EpiSwiglu = EpiSwigluT<false>;
struct EpiMoeDown {
    static constexpr bool PERM = true, MID = false;
    bf16* Y0; bf16* Yt; const float* slot_gate; int ks; float dsc;
    __device__ __forceinline__ void operator()(const f32x4 (&acc)[2][2][4][2], const Unit& u, int wr, int wc, int fr, int fq) const {
        int rl0 = wr * 64 + fr, cl0 = wc * 32 + 8 * fq; asm volatile("" : "+v"(rl0), "+v"(cl0));
        bf16* base; int ld;
        if (u.kidx == 0) { base = Y0 + (size_t)(u.pm * BM) * DM + u.pn * BM; ld = DM; } else { base = Yt + (size_t)(u.tail * (ks - 1) + u.kidx - 1) * 65536; ld = 256; }
#pragma unroll
        for (int ai = 0; ai < 2; ++ai)
#pragma unroll
            for (int m = 0; m < 4; ++m) { const int rl = rl0 + ai * HALF + m * 16; const float gt = slot_gate[u.pm * BM + rl] * dsc; bf16* op = base + (size_t)rl * ld + cl0;
#pragma unroll
                for (int bj = 0; bj < 2; ++bj) { const f32x4 v0 = acc[ai][bj][m][0] * gt, v1 = acc[ai][bj][m][1] * gt;
                    u32x4 w; w.x = cvt_pk_bf16(v0[0], v0[1]); w.y = cvt_pk_bf16(v0[2], v0[3]); w.z = cvt_pk_bf16(v1[0], v1[1]); w.w = cvt_pk_bf16(v1[2], v1[3]);
                    *(u32x4*)(op + bj * HALF) = w; } }
    }
};
template <class Epi, bool ALIGN_EPI = true, bool SP2 = true, int ES = 2>
__device__ __forceinline__ void gemm_phase(LAS unsigned char* lds, int wv, const Gemm g, const Order& S, const Epi& E) {
    int wid = wv; asm volatile("" : "+s"(wid));
    const int tid = fresh_tid(wid), lane = tid & 63, wr = wid >> 2, wc = wid & 3, fr = lane & 15, fq = lane >> 4;
    const int K = g.K;
    unsigned voffA[2], voffB[2];
#pragma unroll
    for (int i = 0; i < 2; ++i) { int R, C; stage_rc(tid * 16 + i * 8192, R, C); const int Rb = (Epi::PERM && ES == 2) ? ((R & ~31) + perm32(R & 31)) : R;
        voffA[i] = (unsigned)(R * g.lda * ES + C * 2); voffB[i] = (unsigned)(Rb * K * ES + C * 2); }
    const int kstep = BK * 2;
    const int hstepA = HALF * g.lda * ES, hstepB = HALF * K * ES;
    const unsigned ldsw = (unsigned)wid * 1024u;
    const int aoff = lds_byte(wr * 64 + fr, fq * 8), boff = lds_byte(wc * 32 + fr, fq * 8);
#define PG8_SA(b, h) (((b) * 2 + (h)) * HTB)
#define PG8_SB(b, h) ((4 + (b) * 2 + (h)) * HTB)
#define PG8_RS(p) __builtin_amdgcn_make_buffer_rsrc((void*)(p), 0, 0x7fffffff, 0x00020000)
#define PG8_STAGE(bufoff, gbase, soff, voff) do { _Pragma("unroll") for (int _i = 0; _i < 2; ++_i) \
        __builtin_amdgcn_raw_ptr_buffer_load_lds(PG8_RS(gbase), (LAS unsigned*)(lds + (bufoff) + ldsw + _i * 8192), 16, (int)(voff)[_i], (int)(soff), 0, 0); } while (0)
#define PG8_LD1(dst, adr) do { if constexpr (ES == 1) dst.v = __builtin_shufflevector(*(const LAS v4i_t*)(adr), *(const LAS v4i_t*)((adr) + 1024), 0, 1, 2, 3, 4, 5, 6, 7); \
        else { dst.k[0] = *(const LAS bf16x8*)(adr); dst.k[1] = *(const LAS bf16x8*)((adr) + 1024); } } while (0)
#define PG8_LDA(dst, b, h) do { _Pragma("unroll") for (int m = 0; m < 4; ++m) PG8_LD1(dst[m], lds + PG8_SA(b, h) + aoff + m * 2048); } while (0)
#define PG8_LDB(dst, b, h) do { _Pragma("unroll") for (int n = 0; n < 2; ++n) PG8_LD1(dst[n], lds + PG8_SB(b, h) + boff + n * 2048); } while (0)
#define PG8_MMA(ai, bj, At, Bt) do { __builtin_amdgcn_s_setprio(1); _Pragma("unroll") for (int m = 0; m < 4; ++m) _Pragma("unroll") for (int n = 0; n < 2; ++n) { \
        if constexpr (ES == 1) acc[ai][bj][m][n] = __builtin_amdgcn_mfma_scale_f32_16x16x128_f8f6f4(Bt[n].v, At[m].v, acc[ai][bj][m][n], 0, 0, 0, 0, 0, 0);     \
        else { _Pragma("unroll") for (int k = 0; k < 2; ++k) acc[ai][bj][m][n] = __builtin_amdgcn_mfma_f32_16x16x32_bf16(Bt[n].k[k], At[m].k[k], acc[ai][bj][m][n], 0, 0, 0); } } \
        __builtin_amdgcn_s_setprio(0); } while (0)
#define PG8_WAIT_V(n) asm volatile("s_waitcnt vmcnt(" #n ")" ::: "memory")
#define PG8_WAIT_L(n) asm volatile("s_waitcnt lgkmcnt(" #n ")" ::: "memory")
#define PG8_BAR __builtin_amdgcn_s_barrier()
#define PG8_SCHED __builtin_amdgcn_sched_barrier(0)
    Unit cur, nxt; int ui = 0;
    if (!S.next(0, cur)) return;
    f32x4 acc[2][2][4][2];
#pragma unroll
    for (int a = 0; a < 2; ++a)
#pragma unroll
        for (int b = 0; b < 2; ++b)
#pragma unroll
            for (int m = 0; m < 4; ++m)
#pragma unroll
                for (int n = 0; n < 2; ++n) acc[a][b][m][n] = (f32x4){0.f, 0.f, 0.f, 0.f};
    Frag<ES> At[4], B0[2], B1[2];
    const char* cA; const char* cB; S.ptrs(g, cur, cA, cB);
    if constexpr (SP2) {
        PG8_STAGE(PG8_SB(0, 0), cB, 0, voffB); PG8_STAGE(PG8_SB(0, 1), cB, hstepB, voffB); PG8_STAGE(PG8_SA(0, 0), cA, 0, voffA); PG8_STAGE(PG8_SA(0, 1), cA, hstepA, voffA);
        if (wr == 1) PG8_BAR;
        PG8_WAIT_V(2); PG8_BAR;
        PG8_STAGE(PG8_SB(1, 0), cB, kstep, voffB); PG8_STAGE(PG8_SA(1, 0), cA, kstep, voffA); PG8_STAGE(PG8_SB(1, 1), cB, hstepB + kstep, voffB);
        PG8_WAIT_V(6); PG8_BAR;
    } else {
        PG8_STAGE(PG8_SB(0, 0), cB, 0, voffB); PG8_STAGE(PG8_SA(0, 0), cA, 0, voffA); PG8_STAGE(PG8_SB(0, 1), cB, hstepB, voffB); PG8_STAGE(PG8_SA(0, 1), cA, hstepA, voffA);
        if (wr == 1) PG8_BAR;
        PG8_WAIT_V(4); PG8_BAR;
        PG8_STAGE(PG8_SB(1, 0), cB, kstep, voffB); PG8_STAGE(PG8_SA(1, 0), cA, kstep, voffA); PG8_STAGE(PG8_SB(1, 1), cB, hstepB + kstep, voffB);
        PG8_WAIT_V(6); PG8_BAR;
    }
    for (;;) {
        const bool has_next = S.next(ui + 1, nxt);
        const char* nA = cA; const char* nB = cB; if (has_next) S.ptrs(g, nxt, nA, nB);
        const int nt = cur.nt;
        for (int t = 0; t < nt; t += 2) {
            if constexpr (Epi::MID) { if (t == (nt >> 1)) { const int le = lane_id_fresh(); E.mid(acc, cur, wr, wc, le & 15, le >> 4); } }
            const bool last = (t == nt - 2);
            const int s1 = (t + 1) * kstep, s2 = last ? 0 : (t + 2) * kstep, s3 = s2 + kstep;
            const char* a2 = last ? nA : cA; const char* b2 = last ? nB : cB;
            if constexpr (SP2) {
            PG8_LDB(B0, 0, 0); PG8_LDB(B1, 0, 1); PG8_SCHED; PG8_LDA(At, 0, 0); PG8_STAGE(PG8_SA(1, 1), cA, s1 + hstepA, voffA);
            PG8_WAIT_V(8); PG8_WAIT_L(0); PG8_BAR; PG8_MMA(0, 0, At, B0); PG8_MMA(0, 1, At, B1); PG8_BAR; PG8_SCHED;
            PG8_LDA(At, 0, 1); PG8_STAGE(PG8_SB(0, 0), b2, s2, voffB); PG8_STAGE(PG8_SB(0, 1), b2, s2 + hstepB, voffB); PG8_STAGE(PG8_SA(0, 0), a2, s2, voffA);
            PG8_WAIT_V(8); PG8_WAIT_L(0); PG8_BAR; PG8_MMA(1, 0, At, B0); PG8_MMA(1, 1, At, B1); PG8_BAR; PG8_SCHED;
            PG8_LDB(B0, 1, 0); PG8_LDB(B1, 1, 1); PG8_SCHED; PG8_LDA(At, 1, 0); PG8_STAGE(PG8_SA(0, 1), a2, s2 + hstepA, voffA);
            PG8_WAIT_V(8); PG8_WAIT_L(0); PG8_BAR; PG8_MMA(0, 0, At, B0); PG8_MMA(0, 1, At, B1); PG8_BAR; PG8_SCHED;
            PG8_LDA(At, 1, 1); PG8_STAGE(PG8_SB(1, 0), b2, s3, voffB); PG8_STAGE(PG8_SB(1, 1), b2, s3 + hstepB, voffB); PG8_STAGE(PG8_SA(1, 0), a2, s3, voffA);
            PG8_WAIT_V(8); PG8_WAIT_L(0); PG8_BAR; PG8_MMA(1, 0, At, B0); PG8_MMA(1, 1, At, B1); PG8_BAR; PG8_SCHED;
            } else {
            PG8_LDB(B0, 0, 0); PG8_SCHED; PG8_LDA(At, 0, 0); PG8_STAGE(PG8_SA(1, 1), cA, s1 + hstepA, voffA);
            PG8_WAIT_L(8); PG8_BAR; PG8_WAIT_L(0); PG8_MMA(0, 0, At, B0); PG8_BAR; PG8_SCHED;
            PG8_LDB(B1, 0, 1); PG8_STAGE(PG8_SB(0, 0), b2, s2, voffB);
            PG8_BAR; PG8_WAIT_L(0); PG8_MMA(0, 1, At, B1); PG8_BAR;
            PG8_LDA(At, 0, 1); PG8_STAGE(PG8_SA(0, 0), a2, s2, voffA);
            PG8_BAR; PG8_WAIT_L(0); PG8_MMA(1, 0, At, B0); PG8_BAR; PG8_SCHED;
            PG8_STAGE(PG8_SB(0, 1), b2, s2 + hstepB, voffB);
            PG8_WAIT_V(6); PG8_BAR; PG8_MMA(1, 1, At, B1); PG8_BAR;
            PG8_LDB(B0, 1, 0); PG8_SCHED; PG8_LDA(At, 1, 0); PG8_STAGE(PG8_SA(0, 1), a2, s2 + hstepA, voffA);
            PG8_WAIT_L(8); PG8_BAR; PG8_WAIT_L(0); PG8_MMA(0, 0, At, B0); PG8_BAR; PG8_SCHED;
            PG8_LDB(B1, 1, 1); PG8_STAGE(PG8_SB(1, 0), b2, s3, voffB);
            PG8_BAR; PG8_WAIT_L(0); PG8_MMA(0, 1, At, B1); PG8_BAR;
            PG8_LDA(At, 1, 1); PG8_STAGE(PG8_SA(1, 0), a2, s3, voffA);
            PG8_BAR; PG8_WAIT_L(0); PG8_MMA(1, 0, At, B0); PG8_BAR; PG8_SCHED;
            PG8_STAGE(PG8_SB(1, 1), b2, s3 + hstepB, voffB);
            PG8_WAIT_V(6); PG8_BAR; PG8_MMA(1, 1, At, B1); PG8_BAR;
            }
        }
        if constexpr (ALIGN_EPI) { if (wr == 0) PG8_BAR; }
        { const int le = lane_id_fresh(); E(acc, cur, wr, wc, le & 15, le >> 4); }
        if (!has_next) break;
#pragma unroll
        for (int a = 0; a < 2; ++a)
#pragma unroll
            for (int b = 0; b < 2; ++b)
#pragma unroll
                for (int m = 0; m < 4; ++m)
#pragma unroll
                    for (int n = 0; n < 2; ++n) acc[a][b][m][n] = (f32x4){0.f, 0.f, 0.f, 0.f};
        cur = nxt; cA = nA; cB = nB; ++ui;
        if constexpr (ALIGN_EPI) { if (wr == 1) PG8_BAR; }
    }
    PG8_WAIT_V(0);
    if constexpr (!ALIGN_EPI) { if (wr == 0) PG8_BAR; }
    PG8_BAR;
#undef PG8_SA
#undef PG8_SB
#undef PG8_STAGE
#undef PG8_RS
#undef PG8_LDA
#undef PG8_LDB
#undef PG8_MMA
#undef PG8_LD1
#undef PG8_WAIT_V
#undef PG8_WAIT_L
#undef PG8_BAR
#undef PG8_SCHED
}
}

#define XB_TMO      128
#define XB_XCNT(j)  (256  + 64 * (j))
#define XB_XSUB(j)  (1280 + 64 * (j))
#define XB_XGEN(j)  (2304 + 64 * (j))
#define XB_TOP      3328
#define XB_TOPGEN   3392
#define XCD_BAR_WORDS 3456
#define XB_SPIN_CAP (1u << 18)
__device__ __forceinline__ unsigned xb_ld(unsigned* p)              { return __hip_atomic_load(p, __ATOMIC_RELAXED, __HIP_MEMORY_SCOPE_AGENT); }
__device__ __forceinline__ unsigned xb_add(unsigned* p, unsigned v) { return __hip_atomic_fetch_add(p, v, __ATOMIC_RELAXED, __HIP_MEMORY_SCOPE_AGENT); }
__device__ __forceinline__ unsigned xb_xcc_id() { return (unsigned)__builtin_amdgcn_s_getreg((3 << 11) | 20) & 0xFu; }
#define XB_SPIN(cond, bar) do { unsigned _sp = 0; while (cond) { __builtin_amdgcn_s_sleep(1); \
    if ((++_sp & 255u) == 0u) { if (xb_ld(&(bar)[XB_TMO])) break; if (_sp > XB_SPIN_CAP) { atomicAdd(&(bar)[XB_TMO], 1u); break; } } } } while (0)
struct XcdBarrier { unsigned* bar; unsigned x; volatile LAS unsigned* st; };
__device__ __forceinline__ XcdBarrier xcd_barrier_post(unsigned* bar, volatile LAS unsigned* st, int wv) {
    XcdBarrier b; b.bar = bar; b.x = (unsigned)wv; b.st = st;
    if (fresh_tid(wv) == 0) (void)xb_add(&bar[XB_XCNT(xb_xcc_id())], 1u);
    return b;
}
__device__ __forceinline__ void xcd_barrier_complete(unsigned* bar, unsigned x, unsigned& nloc, unsigned& nx) {
    const unsigned G = gridDim.x * gridDim.y * gridDim.z;
    unsigned sum, cnt, mine, sp = 0u;
    for (;;) {
        sum = 0u; cnt = 0u; mine = 0u;
#pragma unroll
        for (unsigned j = 0; j < 16; ++j) { const unsigned c = xb_ld(&bar[XB_XCNT(j)]); sum += c; cnt += (c > 0u) ? 1u : 0u; mine = (j == x) ? c : mine; }
        if (sum == G) break;
        __builtin_amdgcn_s_sleep(1);
        if ((++sp & 255u) == 0u) { if (xb_ld(&bar[XB_TMO])) break; if (sp > XB_SPIN_CAP) { atomicAdd(&bar[XB_TMO], 1u); break; } }
    }
    nloc = mine > 0u ? mine : 1u; nx = cnt > 0u ? cnt : 1u;
}
__device__ __forceinline__ void xcd_barrier(const XcdBarrier& b) {
    asm volatile("s_waitcnt vmcnt(0)" ::: "memory");
    __syncthreads();
    if (fresh_tid((int)b.x) == 0) {
        unsigned* bar = b.bar; const unsigned bx_ = xb_xcc_id();
        __builtin_amdgcn_s_waitcnt(0);
        unsigned nloc = b.st[0], nx = b.st[1];
        if (nloc == 0u) { xcd_barrier_complete(bar, bx_, nloc, nx); b.st[0] = nloc; b.st[1] = nx; }
        const unsigned old = xb_add(&bar[XB_XSUB(bx_)], 1u);
        const unsigned gen = old / nloc;
        if (old + 1u == (gen + 1u) * nloc) {
            __builtin_amdgcn_fence(__ATOMIC_RELEASE, "agent");
            asm volatile("s_waitcnt vmcnt(0)" ::: "memory");
            const unsigned og = xb_add(&bar[XB_TOP], 1u);
            const unsigned tg = og / nx;
            if (og + 1u == (tg + 1u) * nx) xb_add(&bar[XB_TOPGEN], 1u);
            else XB_SPIN(xb_ld(&bar[XB_TOPGEN]) == tg, bar);
            __builtin_amdgcn_fence(__ATOMIC_ACQUIRE, "agent");
            xb_add(&bar[XB_XGEN(bx_)], 1u);
            asm volatile("s_waitcnt vmcnt(0)" ::: "memory");
        } else {
            XB_SPIN(xb_ld(&bar[XB_XGEN(bx_)]) == gen, bar);
            __builtin_amdgcn_fence(__ATOMIC_ACQUIRE, "agent");
            asm volatile("s_waitcnt vmcnt(0)" ::: "memory");
        }
    }
    __syncthreads();
}

__device__ __forceinline__ void cnt_signal(unsigned* p, int wv) {
    asm volatile("s_waitcnt vmcnt(0)" ::: "memory");
    __syncthreads();
    if (fresh_tid(wv) == 0) { __builtin_amdgcn_fence(__ATOMIC_RELEASE, "agent"); asm volatile("s_waitcnt vmcnt(0)" ::: "memory"); (void)xb_add(p, 1u); }
}
__device__ __forceinline__ void cnt_wait(unsigned* p, unsigned n, unsigned* bar, int wv) {
    if (fresh_tid(wv) == 0) { XB_SPIN(xb_ld(p) < n, bar); __builtin_amdgcn_fence(__ATOMIC_ACQUIRE, "agent"); asm volatile("s_waitcnt vmcnt(0)" ::: "memory"); }
    __syncthreads();
}
struct MatDesc { const float* src; bf16* dst; const float* gain; int K, N, mode, item0, ldd, pad; };
constexpr int NMAT = 43;
struct Args {
    const float* in[28]; float* out; unsigned char* ws;
    MatDesc mat[NMAT];
    int total_items, ph_lo, ph_hi, bg_item0;
    int nch0, nch_total, pad0, pad1;
};

#define GAS __attribute__((address_space(1)))
struct Ctx {
    LAS unsigned char* lds; unsigned* ctl; GAS unsigned char* ws;
    int vcu, G, wv;
    unsigned* ccnt; unsigned* gcnt;
    unsigned* ucnt;
};
struct Lane { int tid, lane, wave, gw, NGW; };
__device__ __forceinline__ Lane mk_lane(const Ctx& c) { Lane L; int w = c.wv; asm volatile("" : "+s"(w)); L.tid = fresh_tid(w); L.lane = L.tid & 63; L.wave = w; L.gw = c.vcu * 8 + L.wave; L.NGW = c.G * 8; return L; }

__device__ __forceinline__ int perm64(int r) { return (r & 15) + 16 * ((r >> 5) & 1) + 32 * ((r >> 4) & 1); }
__device__ __forceinline__ int win_dst_row(int n) {
    if (n < 2560) return n;
    if (n < 2584) return ZG + (n - 2560);
    if (n < 3352) return ZQA + (n - 2584);
    if (n < 3864) return ZKVA + (n - 3352);
    if (n < 3928) return ZKR + perm64(n - 3864);
    return ZM + (n - 3928);
}
__device__ __forceinline__ void conv_load(const MatDesc& d, int item, int lane, f32x4 (&v)[8], int& n, int& k0) {
    const int N = d.N, nblk = (N + 31) >> 5, kb = item / nblk, nb = item - kb * nblk;
    k0 = 64 * kb + 8 * (lane & 7); n = 32 * nb + 4 * (lane >> 3);
    if (n < N) {
#pragma unroll
        for (int r = 0; r < 8; ++r) v[r] = __builtin_nontemporal_load((const f32x4*)(d.src + (size_t)(k0 + r) * N + n)); }
}
__device__ __forceinline__ void conv_store(const MatDesc& d, int lane, f32x4 (&v)[8], int n, int k0) {
    if (n < d.N) {
        if (d.gain) { const f32x4 g0 = *(const f32x4*)(d.gain + k0), g1 = *(const f32x4*)(d.gain + k0 + 4);
#pragma unroll
            for (int r = 0; r < 4; ++r) { v[r] = v[r] * g0[r]; v[4 + r] = v[4 + r] * g1[r]; } }
        int drow;
        if (d.mode == 0) drow = n; else if (d.mode == 1) drow = win_dst_row(n); else if (d.mode == 4) { const int hq = n / 192, dq = n - hq * 192; drow = dq < 128 ? hq * 128 + dq : 1024 + hq * 64 + perm64(dq - 128); }
        else drow = 256 * (n >> 7) + (n & 127) + (d.mode == 3 ? 128 : 0);
        if (d.pad) { const float qs = __builtin_ldexpf(1.0f, d.pad);
            { const int q = drow & 31; drow = (drow & ~31) + 16 * ((q >> 2) & 1) + 4 * (q >> 3) + (q & 3); }
#pragma unroll
            for (int e = 0; e < 4; ++e) {
                u32x2 w; w.x = pk4_f8(v[0][e] * qs, v[1][e] * qs, v[2][e] * qs, v[3][e] * qs); w.y = pk4_f8(v[4][e] * qs, v[5][e] * qs, v[6][e] * qs, v[7][e] * qs);
                *(u32x2*)((unsigned char*)d.dst + (size_t)(drow + e) * d.ldd + k0) = w; } }
        else {
#pragma unroll
        for (int e = 0; e < 4; ++e) {
            u32x4 w; w.x = cvt_pk_bf16(v[0][e], v[1][e]); w.y = cvt_pk_bf16(v[2][e], v[3][e]); w.z = cvt_pk_bf16(v[4][e], v[5][e]); w.w = cvt_pk_bf16(v[6][e], v[7][e]);
            *(u32x4*)(d.dst + (size_t)(drow + e) * d.ldd + k0) = w; } } }
}
__device__ __forceinline__ void conv_chunk(const Args& a, const Ctx& c, int chunk) {
    const Lane L = mk_lane(c);
    const int base = a.bg_item0 + chunk * 128;
    int mi = 5;
    for (int i = 0; i < 16; i += 2) {
        const int it0 = base + L.wave + 8 * i, it1 = it0 + 8;
        if (it0 >= a.total_items) break;
        while (mi + 1 < NMAT && it0 >= a.mat[mi + 1].item0) ++mi;
        int mj = mi; while (mj + 1 < NMAT && it1 >= a.mat[mj + 1].item0) ++mj;
        f32x4 v0[8], v1[8]; int n0, k00, n1 = 0, k01 = 0; const bool two = it1 < a.total_items;
        conv_load(a.mat[mi], it0 - a.mat[mi].item0, L.lane, v0, n0, k00);
        if (two) conv_load(a.mat[mj], it1 - a.mat[mj].item0, L.lane, v1, n1, k01);
        conv_store(a.mat[mi], L.lane, v0, n0, k00);
        if (two) conv_store(a.mat[mj], L.lane, v1, n1, k01);
    }
}
__device__ __forceinline__ int attn_item_cost(int id) {
    const int kind = id >> 8, idx = id & 255;
    if (kind == 0) return 160 * ((idx >> 4) + 1);
    const int chunk = idx >> 2;
    if (kind == 1) return 32 * (chunk + 1) + 8;
    return 32 * (chunk + 1 < 9 ? chunk + 1 : 9) + 8;
}
__device__ __forceinline__ void p0_prologue(const Args& a, const Ctx& c) {
    const Lane L = mk_lane(c);
    { int mi = 0;
      for (int it = L.gw; it < a.bg_item0; it += L.NGW) {
          while (mi + 1 < NMAT && it >= a.mat[mi + 1].item0) ++mi;
          { f32x4 v[8]; int n = 0, k0 = 0; conv_load(a.mat[mi], it - a.mat[mi].item0, L.lane, v, n, k0); conv_store(a.mat[mi], L.lane, v, n, k0); }
      } }
    for (int l = 0; l < 2; ++l) { u32x4* p = (u32x4*)(c.ws + WS_WL + l * WL_STRIDE + WL_IN + (size_t)3928 * DM * 2); const int n16 = 168 * DM * 2 / 16;
        for (int i = L.gw * 64 + L.lane; i < n16; i += L.NGW * 64) p[i] = (u32x4){0u, 0u, 0u, 0u}; }
    { float* tab = (float*)(c.ws + WS_TAB); const int gt = L.gw * 64 + L.lane, NT = L.NGW * 64;
      const double LT = 13.122363377404328;
      for (int i = gt; i < SEQ * 16; i += NT) { const int pos = i >> 4, k = i & 15; const float inv = (float)exp(-LT * (double)k / 16.0); const float ang = (float)pos * inv;
          const double rev = (double)ang * 0.15915494309189535; const float fr = (float)(rev - floor(rev));
          tab[TAB_COS_TOK / 4 + i] = __builtin_amdgcn_cosf(fr); tab[TAB_SIN_TOK / 4 + i] = __builtin_amdgcn_sinf(fr); }
      for (int i = gt; i < SEQ * 32; i += NT) { const int pos = i >> 5, k = i & 31; const float inv = (float)exp(-LT * (double)k / 32.0); const float ang = (float)pos * inv;
          const double rev = (double)ang * 0.15915494309189535; const float fr = (float)(rev - floor(rev));
          tab[TAB_COS_MLA / 4 + i] = __builtin_amdgcn_cosf(fr); tab[TAB_SIN_MLA / 4 + i] = __builtin_amdgcn_sinf(fr); }
      for (int i = gt; i < 256 * 16; i += NT) { const int n = i >> 4, k = i & 15; const int pos = 16 * n + 31; const float inv = (float)exp(-LT * (double)k / 16.0); const float ang = (float)pos * inv;
          const double rev = (double)ang * 0.15915494309189535; const float fr = (float)(rev - floor(rev));
          tab[TAB_COS_CMP / 4 + i] = __builtin_amdgcn_cosf(fr); tab[TAB_SIN_CMP / 4 + i] = __builtin_amdgcn_sinf(fr); }
      int* order = (int*)(c.ws + WS_TAB + TAB_ORDER);
      for (int i = gt; i < 512; i += NT) { const int ci = attn_item_cost(i); int rank = 0;
          for (int j = 0; j < 512; ++j) { const int cj = attn_item_cost(j); rank += (cj > ci || (cj == ci && j < i)) ? 1 : 0; }
          order[rank] = i; }
    }
}

template <bool ROUTER, bool XBF16 = false> __device__ __forceinline__ void norm_phase(const Ctx& c, const void* xv, const float* g, bf16* h, const float* wr, float* route) {
    const Lane L = mk_lane(c);
    const f32x4* g4 = (const f32x4*)g;
    for (int row = L.gw; row < T; row += L.NGW) {
        f32x4 v[8]; float ss = 0.f;
#pragma unroll
        for (int j = 0; j < 8; ++j) {
            if (XBF16) { const u32x2 w = ((const u32x2*)((const bf16*)xv + (size_t)row * DM))[L.lane + 64 * j]; v[j] = (f32x4){bflo(w.x), bfhi(w.x), bflo(w.y), bfhi(w.y)}; }
            else v[j] = ((const f32x4*)((const float*)xv + (size_t)row * DM))[L.lane + 64 * j];
            ss += (v[j][0] * v[j][0] + v[j][1] * v[j][1]) + (v[j][2] * v[j][2] + v[j][3] * v[j][3]); }
        const float r = 1.0f / sqrtf(wave_sum(ss) * (1.0f / DM) + EPS);
        u32x2* o = (u32x2*)(h + (size_t)row * DM) + L.lane;
        float lg[8];
        if (ROUTER) {
#pragma unroll
            for (int e = 0; e < 8; ++e) lg[e] = 0.f; }
#pragma unroll
        for (int j = 0; j < 8; ++j) { const f32x4 gg = g4[L.lane + 64 * j]; v[j] = v[j] * r * gg;
            if (ROUTER) ((unsigned*)((unsigned char*)h + (size_t)row * DM))[L.lane + 64 * j] = pk4_f8(v[j][0] * F8_A_SCALE, v[j][1] * F8_A_SCALE, v[j][2] * F8_A_SCALE, v[j][3] * F8_A_SCALE);
            else { u32x2 w; w.x = cvt_pk_bf16(v[j][0], v[j][1]); w.y = cvt_pk_bf16(v[j][2], v[j][3]); o[64 * j] = w; }
            if (ROUTER) { const f32x4* wp = (const f32x4*)(wr + (size_t)(4 * (L.lane + 64 * j)) * 8);
#pragma unroll
                for (int q = 0; q < 4; ++q) { const f32x4 w0 = wp[2 * q], w1 = wp[2 * q + 1]; const float y = v[j][q];
                    lg[0] += y * w0[0]; lg[1] += y * w0[1]; lg[2] += y * w0[2]; lg[3] += y * w0[3]; lg[4] += y * w1[0]; lg[5] += y * w1[1]; lg[6] += y * w1[2]; lg[7] += y * w1[3]; } } }
        if (ROUTER) {
#pragma unroll
            for (int e = 0; e < 8; ++e) lg[e] = wave_sum(lg[e]);
            int i0 = 0; float m0 = lg[0];
#pragma unroll
            for (int e = 1; e < 8; ++e) if (lg[e] > m0) { m0 = lg[e]; i0 = e; }
            int i1 = -1; float m1 = -3.0e38f;
#pragma unroll
            for (int e = 0; e < 8; ++e) if (e != i0 && lg[e] > m1) { m1 = lg[e]; i1 = e; }
            const float ex = __expf(m1 - m0), g0 = 1.0f / (1.0f + ex), g1 = ex / (1.0f + ex);
            if (L.lane == 0) { f32x4 o4; o4[0] = __int_as_float(i0); o4[1] = __int_as_float(i1); o4[2] = g0; o4[3] = g1; *(f32x4*)(route + (size_t)row * 4) = o4; }
        }
    }
}

__device__ __forceinline__ void load16(const bf16* p, float (&v)[16]) { const u32x4 a = *(const u32x4*)p, b = *(const u32x4*)(p + 8); float t0[8], t1[8]; unpack8(a, t0); unpack8(b, t1);
#pragma unroll
    for (int i = 0; i < 8; ++i) { v[i] = t0[i]; v[8 + i] = t1[i]; } }
__device__ __forceinline__ void store16(bf16* p, const float (&v)[16]) { *(u32x4*)p = pack8f(v); *(u32x4*)(p + 8) = pack8f(v + 8); }
__device__ __forceinline__ void chunk_norm_rope(float (&v)[16], int sub, bool do_norm, const float* gvec, bool do_rope, const float* cs, const float* sn) {
    float ss = 0.f;
#pragma unroll
    for (int i = 0; i < 16; ++i) ss += v[i] * v[i];
    ss += shx(ss, 1); ss += shx(ss, 2); ss += shx(ss, 4);
    const float r = do_norm ? 1.0f / sqrtf(ss * (1.0f / 128.0f) + EPS) : 1.0f;
#pragma unroll
    for (int i = 0; i < 16; ++i) { const float gg = do_norm ? gvec[sub * 16 + i] : 1.0f; v[i] = v[i] * r * gg; }
#pragma unroll
    for (int i = 0; i < 16; ++i) { const float pv = shx(v[i], 1); const float cc = cs[i], s2 = sn[i];
        const float o = (sub == 0) ? v[i] * cc - pv * s2 : v[i] * cc + pv * s2; if (do_rope && sub < 2) v[i] = o; }
}
__device__ __forceinline__ void postz_phase(const Ctx& c, const Args& a, int l) {
    const Lane L = mk_lane(c);
    const bf16* z = (const bf16*)(c.ws + WS_Z);
    const float* tab = (const float*)(c.ws + WS_TAB);
    const float* qg = a.in[3] + l * 128; const float* kg = a.in[4] + l * 384;
    const float* qag = a.in[9] + l * QLORA; const float* kvag = a.in[11] + l * KVLORA; const float* krg = a.in[16] + l * 64;
    bf16* Qn = (bf16*)(c.ws + WS_QN); bf16* qan = (bf16*)(c.ws + WS_QAN); bf16* kvan = (bf16*)(c.ws + WS_KVAN); bf16* Kr = (bf16*)(c.ws + WS_KR); float* gn = (float*)(c.ws + WS_GNSA);
    const int lane = L.lane, sub = lane & 7, ch = lane >> 3;
    for (int row = L.gw; row < T; row += L.NGW) {
        const bf16* zr = z + (size_t)row * DINP; const int b = row / SEQ, s = row % SEQ;
        const float* cs = tab + TAB_COS_TOK / 4 + s * 16; const float* sn = tab + TAB_SIN_TOK / 4 + s * 16;
        float v[16];
        load16(zr + ZQ + lane * 16, v); chunk_norm_rope(v, sub, true, qg, true, cs, sn); store16(Qn + (size_t)row * 1024 + lane * 16, v);
#pragma unroll
        for (int pass = 0; pass < 2; ++pass) {
            const int chunk = pass == 0 ? ch : 8 + (ch & 3); const int br = chunk >> 2, kv = (chunk >> 1) & 1, g = chunk & 1;
            load16(zr + ZKV + chunk * 128 + sub * 16, v);
            const bool nr = (kv == 0) && (br >= 1);
            chunk_norm_rope(v, sub, nr, kg + br * 128, nr, cs, sn);
            bf16* dst = (bf16*)(c.ws + WS_NSAKV + (size_t)(br * 2 + kv) * NSAKV_ONE) + ((size_t)(b * NG + g) * SEQ + s) * HD + sub * 16;
            if (pass == 0 || lane < 32) store16(dst, v);
        }
        { const u32x2* p = (const u32x2*)(zr + ZQA + lane * 12); float f[12]; float ss = 0.f;
#pragma unroll
          for (int j = 0; j < 3; ++j) { const u32x2 w = p[j]; f[4 * j] = bflo(w.x); f[4 * j + 1] = bfhi(w.x); f[4 * j + 2] = bflo(w.y); f[4 * j + 3] = bfhi(w.y); }
#pragma unroll
          for (int j = 0; j < 12; ++j) ss += f[j] * f[j];
          const float r = 1.0f / sqrtf(wave_sum(ss) * (1.0f / QLORA) + EPS);
          u32x2* o = (u32x2*)(qan + (size_t)row * QLORA + lane * 12);
#pragma unroll
          for (int j = 0; j < 3; ++j) { u32x2 w; w.x = cvt_pk_bf16(f[4 * j] * r * qag[lane * 12 + 4 * j], f[4 * j + 1] * r * qag[lane * 12 + 4 * j + 1]);
              w.y = cvt_pk_bf16(f[4 * j + 2] * r * qag[lane * 12 + 4 * j + 2], f[4 * j + 3] * r * qag[lane * 12 + 4 * j + 3]); o[j] = w; } }
        { const u32x4 w = *(const u32x4*)(zr + ZKVA + lane * 8); float f[8]; unpack8(w, f); float ss = 0.f;
#pragma unroll
          for (int j = 0; j < 8; ++j) ss += f[j] * f[j];
          const float r = 1.0f / sqrtf(wave_sum(ss) * (1.0f / KVLORA) + EPS);
#pragma unroll
          for (int j = 0; j < 8; ++j) f[j] = f[j] * r * kvag[lane * 8 + j];
          *(u32x4*)(kvan + (size_t)row * KVLORA + lane * 8) = pack8f(f); }
        { const float f = bf2f(zr[ZKR + lane]); const float r = 1.0f / sqrtf(wave_sum(f * f) * (1.0f / 64.0f) + EPS); const float y = f * r * krg[lane];
          const float pv = shx(y, 32); const int i = lane & 31; const float cc = tab[TAB_COS_MLA / 4 + s * 32 + i], s2 = tab[TAB_SIN_MLA / 4 + s * 32 + i];
          const float o = lane < 32 ? y * cc - pv * s2 : y * cc + pv * s2;
          Kr[(size_t)row * 64 + lane] = (bf16)(cvt_pk_bf16(o, 0.f) & 0xffffu); }
        if (lane < 24) gn[(size_t)row * 24 + lane] = sigmoidf_(bf2f(zr[ZG + lane]));
    }
}

__device__ __forceinline__ void postmla_phase(const Ctx& c, const Args& a, int l) {
    const Lane L = mk_lane(c);
    const bf16* Qraw = (const bf16*)(c.ws + WS_QRAW); const bf16* KVraw = (const bf16*)(c.ws + WS_KVRAW);
    bf16* Qm = (bf16*)(c.ws + WS_QM); bf16* Km = (bf16*)(c.ws + WS_KM);
    const float* tab = (const float*)(c.ws + WS_TAB);
    const float* mqg = a.in[13] + l * 128; const float* mqrg = a.in[14] + l * 64; const float* mkg = a.in[15] + l * 128;
    const int lane = L.lane, sub = lane & 7, hh = lane >> 3;
    const bf16* z = (const bf16*)(c.ws + WS_Z); const float* krg = a.in[16] + l * 64; bf16* Kr = (bf16*)(c.ws + WS_KR); float* gn = (float*)(c.ws + WS_GNSA);
    for (int row = L.gw; row < T; row += L.NGW) {
        const int s = row % SEQ; float v[16];
        { const bf16* zr = z + (size_t)row * DINP;
          const float f = bf2f(zr[ZKR + lane]); const float r = 1.0f / sqrtf(wave_sum(f * f) * (1.0f / 64.0f) + EPS); const float y = f * r * krg[lane];
          const float pv = shx(y, 32); const int i = lane & 31; const float cc = tab[TAB_COS_MLA / 4 + s * 32 + i], s2 = tab[TAB_SIN_MLA / 4 + s * 32 + i];
          const float o = lane < 32 ? y * cc - pv * s2 : y * cc + pv * s2;
          Kr[(size_t)row * 64 + lane] = (bf16)(cvt_pk_bf16(o, 0.f) & 0xffffu);
          if (lane < 24) gn[(size_t)row * 24 + lane] = sigmoidf_(bf2f(zr[ZG + lane])); }
        load16(Qraw + (size_t)row * 1536 + hh * 192 + sub * 16, v); chunk_norm_rope(v, sub, true, mqg, false, tab, tab); store16(Qm + ((size_t)row * 8 + hh) * 192 + sub * 16, v);
        { const int bb = row / SEQ; const size_t hm = (((size_t)bb * 8 + hh) * SEQ + s) * 128 + sub * 16;
          load16(KVraw + (size_t)row * 2048 + hh * 256 + sub * 16, v); chunk_norm_rope(v, sub, true, mkg, false, tab, tab); store16(Km + hm, v);
          const u32x4 v0 = *(const u32x4*)(KVraw + (size_t)row * 2048 + hh * 256 + 128 + sub * 16), v1 = *(const u32x4*)(KVraw + (size_t)row * 2048 + hh * 256 + 128 + sub * 16 + 8);
          bf16* Vm = (bf16*)(c.ws + WS_VM); *(u32x4*)(Vm + hm) = v0; *(u32x4*)(Vm + hm + 8) = v1; }
        { const u32x4 w = *(const u32x4*)(Qraw + (size_t)row * 1536 + hh * 192 + 128 + sub * 8); float f[8]; unpack8(w, f); float ss = 0.f;
#pragma unroll
          for (int j = 0; j < 8; ++j) ss += f[j] * f[j];
          ss += shx(ss, 1); ss += shx(ss, 2); ss += shx(ss, 4);
          const float r = 1.0f / sqrtf(ss * (1.0f / 64.0f) + EPS);
#pragma unroll
          for (int j = 0; j < 8; ++j) f[j] = f[j] * r * mqrg[sub * 8 + j];
          float o[8];
#pragma unroll
          for (int j = 0; j < 8; ++j) { const float pv = shx(f[j], 4); const int i = 8 * (sub & 3) + j; const float cc = tab[TAB_COS_MLA / 4 + s * 32 + i], s2 = tab[TAB_SIN_MLA / 4 + s * 32 + i];
              o[j] = sub < 4 ? f[j] * cc - pv * s2 : f[j] * cc + pv * s2; }
          *(u32x4*)(Qm + ((size_t)row * 8 + hh) * 192 + 128 + sub * 8) = pack8f(o); }
    }
}

__device__ __forceinline__ void compress_phase(const Ctx& c, const Args& a, int l, int u0, int ustep) {
    const Lane L = mk_lane(c);
    const float* tab = (const float*)(c.ws + WS_TAB);
    const float* kg0 = a.in[4] + l * 384;
    LAS float* P = (LAS float*)c.lds;
    const int lane = L.lane, w = L.wave, r = lane & 31, h = lane >> 5;
    for (int u = u0; u < 64; u += ustep) {
        const int nblk = u & 7, kv = (u >> 3) & 1, g = (u >> 4) & 1, b = u >> 5;
        const bf16* src = (const bf16*)(c.ws + WS_NSAKV + (size_t)kv * NSAKV_ONE) + (size_t)(b * NG + g) * SEQ * HD;
        const float* pe = (kv == 0 ? a.in[5] : a.in[6]) + l * 32 * 128;
        const bf16* wt = (const bf16*)(c.ws + WS_WL + l * WL_STRIDE + (kv == 0 ? WL_CK : WL_CV)) + (size_t)r * 4096;
        const int n = 32 * nblk + r;
        f32x16 acc[4];
#pragma unroll
        for (int eb = 0; eb < 4; ++eb)
#pragma unroll
            for (int i = 0; i < 16; ++i) acc[eb][i] = 0.f;
#pragma unroll 4
        for (int s = 0; s < 32; ++s) {
            const int k = 512 * w + 16 * s + 8 * h, lt = k >> 7, d = k & 127; int tok = 16 * n + lt; tok = tok < SEQ ? tok : SEQ - 1;
            const u32x4 xw = *(const u32x4*)(src + (size_t)tok * HD + d); float xf[8]; unpack8(xw, xf);
            const f32x4 p0 = *(const f32x4*)(pe + lt * 128 + d), p1 = *(const f32x4*)(pe + lt * 128 + d + 4);
            u32x4 bw[4];
#pragma unroll
            for (int eb = 0; eb < 4; ++eb) bw[eb] = *(const u32x4*)(wt + (size_t)eb * 32 * 4096 + k);
#pragma unroll
            for (int i = 0; i < 4; ++i) { xf[i] += p0[i]; xf[4 + i] += p1[i]; }
            const u32x4 aw = pack8f(xf);
#pragma unroll
            for (int eb = 0; eb < 4; ++eb) acc[eb] = __builtin_amdgcn_mfma_f32_32x32x16_bf16(*(const bf16x8*)&aw, *(const bf16x8*)&bw[eb], acc[eb], 0, 0, 0);
        }
        __syncthreads();
#pragma unroll
        for (int eb = 0; eb < 4; ++eb)
#pragma unroll
            for (int i = 0; i < 16; ++i) P[(w * 32 + ((i & 3) + 8 * (i >> 2) + 4 * h)) * 128 + 32 * eb + r] = acc[eb][i];
        __syncthreads();
        { const int nl = L.tid >> 4, e0 = (L.tid & 15) * 8, ng = 32 * nblk + nl; float v[8];
#pragma unroll
          for (int i = 0; i < 8; ++i) v[i] = 0.f;
#pragma unroll
          for (int ww = 0; ww < 8; ++ww) { const f32x4 q0 = *(const LAS f32x4*)(P + (ww * 32 + nl) * 128 + e0), q1 = *(const LAS f32x4*)(P + (ww * 32 + nl) * 128 + e0 + 4);
#pragma unroll
              for (int i = 0; i < 4; ++i) { v[i] += q0[i]; v[4 + i] += q1[i]; } }
          if (kv == 0) {
              float ss = 0.f;
#pragma unroll
              for (int i = 0; i < 8; ++i) ss += v[i] * v[i];
              ss += shx(ss, 1); ss += shx(ss, 2); ss += shx(ss, 4); ss += shx(ss, 8);
              const float rr = 1.0f / sqrtf(ss * (1.0f / 128.0f) + EPS);
#pragma unroll
              for (int i = 0; i < 8; ++i) v[i] = v[i] * rr * kg0[e0 + i];
              const int q = L.tid & 15;
#pragma unroll
              for (int i = 0; i < 8; ++i) { const float pv = shx(v[i], 2); const int ci = (e0 & 15) + i; const float cc = tab[TAB_COS_CMP / 4 + ng * 16 + ci], s2 = tab[TAB_SIN_CMP / 4 + ng * 16 + ci];
                  const float o = q < 2 ? v[i] * cc - pv * s2 : v[i] * cc + pv * s2; if (q < 4) v[i] = o; }
          }
          if (ng >= 255) {
#pragma unroll
              for (int i = 0; i < 8; ++i) v[i] = 0.f; }
          bf16* dst = (bf16*)(c.ws + (kv == 0 ? WS_KC : WS_VC)) + ((size_t)(b * NG + g) * 256 + ng) * HD + e0;
          *(u32x4*)dst = pack8f(v); }
        cnt_signal(c.ccnt + (b * NG + g) * 16, c.wv);
        __syncthreads();
    }
}

constexpr int AT_K = 0, AT_K2 = 32768, AT_V = 49152, AT_IMP = 81920, AT_CTL = 81920 + 16640;
__device__ __forceinline__ unsigned offb(unsigned row, unsigned ch) { return 256u * row + 16u * (ch ^ (((row & 3u) << 2) | ((row >> 2) & 3u))); }
__device__ __forceinline__ unsigned offr(unsigned row, unsigned ch) { return 128u * row + 16u * (ch ^ (row & 7u)); }

struct AttnSrc { const bf16* K; int ks; const bf16* K2; int k2s; const bf16* V; int vs; };

template <int MODE> struct AttnState {
    static constexpr int NQ = (MODE == 1) ? 12 : 8;
    bf16x8 qf[NQ]; unsigned ka[8]; unsigned k2a[4]; unsigned va[4][2];
};
template <int MODE> __device__ __forceinline__ void attn_setup(AttnState<MODE>& st, int lane, const bf16* qrow) {
    const unsigned r = lane & 31, h = lane >> 5;
#pragma unroll
    for (int s = 0; s < AttnState<MODE>::NQ; ++s) st.qf[s] = *(const bf16x8*)(qrow + 16 * s + 8 * h);
#pragma unroll
    for (int s = 0; s < 8; ++s) st.ka[s] = offb(r, 2 * s + h);
#pragma unroll
    for (int s = 0; s < 4; ++s) st.k2a[s] = offr(r, 2 * s + h);
    const unsigned blk = (lane >> 4) & 1, q = (lane & 15) >> 2, p = lane & 3;
#pragma unroll
    for (int cc = 0; cc < 4; ++cc)
#pragma unroll
        for (int tt = 0; tt < 2; ++tt) st.va[cc][tt] = offb(8 * tt + 4 * h + q, 4 * cc + 2 * blk + (p >> 1)) + 8 * (p & 1);
}
template <int MODE> __device__ __forceinline__ void attn_issue(const AttnSrc& S, int j, int tid, u32x4 (&kreg)[2], u32x4& k2reg, u32x4 (&vreg)[2], bool with_v) {
#pragma unroll
    for (int i = 0; i < 2; ++i) { const int id = tid + 512 * i, row = id >> 4, ch = id & 15;
        kreg[i] = *(const u32x4*)((const char*)S.K + (unsigned)(((64 * j + row) * S.ks + 8 * ch) * 2));
        if (with_v) vreg[i] = *(const u32x4*)((const char*)S.V + (unsigned)(((64 * j + row) * S.vs + 8 * ch) * 2)); }
    if (MODE == 1) { const int row = tid >> 3, ch = tid & 7; k2reg = *(const u32x4*)((const char*)S.K2 + (unsigned)(((64 * j + row) * S.k2s + 8 * ch) * 2)); }
}
template <int MODE> __device__ __forceinline__ void attn_write(LAS unsigned char* lds, int cur, int tid, const u32x4 (&kreg)[2], const u32x4& k2reg, const u32x4 (&vreg)[2], bool with_v) {
#pragma unroll
    for (int i = 0; i < 2; ++i) { const int id = tid + 512 * i, row = id >> 4, ch = id & 15;
        *(LAS u32x4*)(lds + AT_K + cur * 16384 + offb(row, ch)) = kreg[i];
        if (with_v) *(LAS u32x4*)(lds + AT_V + cur * 16384 + offb(row, ch)) = vreg[i]; }
    if (MODE == 1) { const int row = tid >> 3, ch = tid & 7; *(LAS u32x4*)(lds + AT_K2 + cur * 8192 + offr(row, ch)) = k2reg; }
}
template <int MODE> __device__ __forceinline__ void attn_scores(const AttnState<MODE>& st, LAS unsigned char* lds, int cur, int j, int lane, int t, u64 rowmask, unsigned W, bool full, bool rowonly, f32x16& p0, f32x16& p1) {
    const unsigned h = lane >> 5;
#pragma unroll
    for (int i = 0; i < 16; ++i) { p0[i] = 0.f; p1[i] = 0.f; }
    LAS unsigned char* kb = lds + AT_K + cur * 16384;
    if constexpr (MODE == 1) {
#pragma unroll
        for (int s = 0; s < 8; ++s) { const bf16x8 k0 = *(const LAS bf16x8*)(kb + st.ka[s]), k1 = *(const LAS bf16x8*)(kb + st.ka[s] + 8192);
            p0 = __builtin_amdgcn_mfma_f32_32x32x16_bf16(k0, st.qf[s], p0, 0, 0, 0); p1 = __builtin_amdgcn_mfma_f32_32x32x16_bf16(k1, st.qf[s], p1, 0, 0, 0); }
        LAS unsigned char* k2p = lds + AT_K2 + cur * 8192;
#pragma unroll
        for (int s = 0; s < 4; ++s) { const bf16x8 k0 = *(const LAS bf16x8*)(k2p + st.k2a[s]), k1 = *(const LAS bf16x8*)(k2p + st.k2a[s] + 4096);
            p0 = __builtin_amdgcn_mfma_f32_32x32x16_bf16(k0, st.qf[8 + s], p0, 0, 0, 0); p1 = __builtin_amdgcn_mfma_f32_32x32x16_bf16(k1, st.qf[8 + s], p1, 0, 0, 0); }
    } else {
    bf16x8 fa[4], fb[4];
#define AT_LDK(dst, s0) do { dst[0] = *(const LAS bf16x8*)(kb + st.ka[s0]); dst[1] = *(const LAS bf16x8*)(kb + st.ka[s0] + 8192); dst[2] = *(const LAS bf16x8*)(kb + st.ka[(s0) + 1]); dst[3] = *(const LAS bf16x8*)(kb + st.ka[(s0) + 1] + 8192); } while (0)
#define AT_MMK(src, s0) do { p0 = __builtin_amdgcn_mfma_f32_32x32x16_bf16(src[0], st.qf[s0], p0, 0, 0, 0); p1 = __builtin_amdgcn_mfma_f32_32x32x16_bf16(src[1], st.qf[s0], p1, 0, 0, 0); \
        p0 = __builtin_amdgcn_mfma_f32_32x32x16_bf16(src[2], st.qf[(s0) + 1], p0, 0, 0, 0); p1 = __builtin_amdgcn_mfma_f32_32x32x16_bf16(src[3], st.qf[(s0) + 1], p1, 0, 0, 0); } while (0)
    AT_LDK(fa, 0); __builtin_amdgcn_sched_barrier(0);
    AT_LDK(fb, 2); __builtin_amdgcn_sched_barrier(0); AT_MMK(fa, 0); __builtin_amdgcn_sched_barrier(0);
    AT_LDK(fa, 4); __builtin_amdgcn_sched_barrier(0); AT_MMK(fb, 2); __builtin_amdgcn_sched_barrier(0);
    AT_LDK(fb, 6); __builtin_amdgcn_sched_barrier(0); AT_MMK(fa, 4); __builtin_amdgcn_sched_barrier(0);
    if (MODE == 1) { LAS unsigned char* k2b = lds + AT_K2 + cur * 8192;
#define AT_LDK2(dst, s0) do { dst[0] = *(const LAS bf16x8*)(k2b + st.k2a[s0]); dst[1] = *(const LAS bf16x8*)(k2b + st.k2a[s0] + 4096); dst[2] = *(const LAS bf16x8*)(k2b + st.k2a[(s0) + 1]); dst[3] = *(const LAS bf16x8*)(k2b + st.k2a[(s0) + 1] + 4096); } while (0)
        AT_LDK2(fa, 0); __builtin_amdgcn_sched_barrier(0); AT_MMK(fb, 6); __builtin_amdgcn_sched_barrier(0);
        AT_LDK2(fb, 2); __builtin_amdgcn_sched_barrier(0); AT_MMK(fa, 8); __builtin_amdgcn_sched_barrier(0);
        AT_MMK(fb, 10);
#undef AT_LDK2
    } else { AT_MMK(fb, 6); }
    __builtin_amdgcn_sched_barrier(0);
#undef AT_LDK
#undef AT_MMK
    }
    if (full) return;
    const float NEG = -__builtin_inff();
    const bool rowok = (MODE == 0) ? (((rowmask >> j) & 1ull) != 0ull) : true;
    if (MODE == 0 && rowonly) {
#pragma unroll
        for (int i = 0; i < 16; ++i) { p0[i] = rowok ? p0[i] : NEG; p1[i] = rowok ? p1[i] : NEG; }
        return; }
#pragma unroll
    for (int i = 0; i < 16; ++i) { const int key0 = 64 * j + (i & 3) + 8 * (i >> 2) + 4 * (int)h, key1 = key0 + 32;
        bool ok0, ok1;
        if (MODE == 2) { ok0 = (16 * key0 + 31 <= t); ok1 = (16 * key1 + 31 <= t); }
        else { ok0 = rowok && ((unsigned)(t - key0) < W); ok1 = rowok && ((unsigned)(t - key1) < W); }
        p0[i] = ok0 ? p0[i] : NEG; p1[i] = ok1 ? p1[i] : NEG; }
}
template <int MODE> __device__ __forceinline__ void attn_pv(const AttnState<MODE>& st, LAS unsigned char* lds, int vbuf, const bf16x8 (&pb)[2][2], f32x16 (&o)[4]) {
    LAS unsigned char* vb = lds + AT_V + vbuf * 16384;
    if constexpr (MODE == 1) {
#pragma unroll
        for (int cc = 0; cc < 4; ++cc)
#pragma unroll
            for (int hs = 0; hs < 4; ++hs) {
                const s16x4 a0 = __builtin_amdgcn_ds_read_tr16_b64_v4i16((LAS s16x4*)(vb + st.va[cc][0] + (hs >> 1) * 8192 + (hs & 1) * 4096));
                const s16x4 a1 = __builtin_amdgcn_ds_read_tr16_b64_v4i16((LAS s16x4*)(vb + st.va[cc][1] + (hs >> 1) * 8192 + (hs & 1) * 4096));
                const bf16x8 vf = {a0[0], a0[1], a0[2], a0[3], a1[0], a1[1], a1[2], a1[3]};
                o[cc] = __builtin_amdgcn_mfma_f32_32x32x16_bf16(vf, pb[hs >> 1][hs & 1], o[cc], 0, 0, 0);
            }
        return;
    }
    s16x4 va0[4][2], va1[4][2];
#define AT_LDV(dst, cc) do { _Pragma("unroll") for (int hs = 0; hs < 4; ++hs) { \
        dst[hs][0] = __builtin_amdgcn_ds_read_tr16_b64_v4i16((LAS s16x4*)(vb + st.va[cc][0] + (hs >> 1) * 8192 + (hs & 1) * 4096)); \
        dst[hs][1] = __builtin_amdgcn_ds_read_tr16_b64_v4i16((LAS s16x4*)(vb + st.va[cc][1] + (hs >> 1) * 8192 + (hs & 1) * 4096)); } } while (0)
#define AT_MMV(src, cc) do { _Pragma("unroll") for (int hs = 0; hs < 4; ++hs) { \
        const bf16x8 vf = {src[hs][0][0], src[hs][0][1], src[hs][0][2], src[hs][0][3], src[hs][1][0], src[hs][1][1], src[hs][1][2], src[hs][1][3]}; \
        o[cc] = __builtin_amdgcn_mfma_f32_32x32x16_bf16(vf, pb[hs >> 1][hs & 1], o[cc], 0, 0, 0); } } while (0)
    AT_LDV(va0, 0); __builtin_amdgcn_sched_barrier(0);
    AT_LDV(va1, 1); __builtin_amdgcn_sched_barrier(0); AT_MMV(va0, 0); __builtin_amdgcn_sched_barrier(0);
    AT_LDV(va0, 2); __builtin_amdgcn_sched_barrier(0); AT_MMV(va1, 1); __builtin_amdgcn_sched_barrier(0);
    AT_LDV(va1, 3); __builtin_amdgcn_sched_barrier(0); AT_MMV(va0, 2); __builtin_amdgcn_sched_barrier(0);
    AT_MMV(va1, 3); __builtin_amdgcn_sched_barrier(0);
#undef AT_LDV
#undef AT_MMV
}
template <int MODE> __device__ __forceinline__ bool attn_tile_full(int j, int tmin, int tmax, u64 andmask, unsigned W) {
    if (MODE == 2) return 16 * (64 * j + 63) + 31 <= tmin;
    return (64 * j + 63 <= tmin) && ((unsigned)(tmax - 64 * j) < W) && (((andmask >> j) & 1ull) != 0ull);
}
constexpr float ATT_THR = 8.0f;
template <int MODE> __device__ __forceinline__ bool attn_tile_empty(int j, int tmin, int tmax, u64 ormask, unsigned W) {
    if (MODE == 2) return 16 * (64 * j) + 31 > tmax;
    return (64 * j > tmax) || ((unsigned)(tmin - (64 * j + 63)) >= W && tmin > 64 * j + 63) || (((ormask >> j) & 1ull) == 0ull);
}
template <int MODE> __device__ __forceinline__ void attn_tile(const AttnState<MODE>& st, LAS unsigned char* lds, int kbuf, int j, int lane, int t, u64 rowmask, unsigned W, float c2,
                                                             int tmin, int tmax, u64 andmask, u64 ormask, f32x16 (&o)[4], float& m, float& l) {
    if (attn_tile_empty<MODE>(j, tmin, tmax, ormask, W)) return;
    f32x16 p0, p1;
    attn_scores<MODE>(st, lds, kbuf, j, lane, t, rowmask, W, attn_tile_full<MODE>(j, tmin, tmax, andmask, W), (MODE == 0) && (64 * j + 63 <= tmin) && ((unsigned)(tmax - 64 * j) < W), p0, p1);
    float pmax = p0[0];
#pragma unroll
    for (int i = 1; i < 16; ++i) pmax = fmaxf(pmax, p0[i]);
#pragma unroll
    for (int i = 0; i < 16; ++i) pmax = fmaxf(pmax, p1[i]);
    { float pa, pb2; pair32(pmax, pa, pb2); asm("v_max_f32 %0, %1, %2" : "=v"(pmax) : "v"(pa), "v"(pb2)); }
    if (!__all((pmax - m) * c2 <= ATT_THR)) {
        const float mn = fmaxf(m, pmax), alpha = fexp2((m - mn) * c2); m = mn; l *= alpha;
#pragma unroll
        for (int cc = 0; cc < 4; ++cc) o[cc] = o[cc] * alpha;
    }
    const float nmb = -m * c2;
#pragma unroll
    for (int i = 0; i < 16; ++i) { p0[i] = fexp2(fma_s(p0[i], c2, nmb)); p1[i] = fexp2(fma_s(p1[i], c2, nmb)); }
    { float sv[16];
#pragma unroll
      for (int i = 0; i < 16; ++i) sv[i] = add_s(p0[i], p1[i]);
#pragma unroll
      for (int i = 0; i < 8; ++i) sv[i] = add_s(sv[i], sv[i + 8]);
#pragma unroll
      for (int i = 0; i < 4; ++i) sv[i] = add_s(sv[i], sv[i + 4]);
      float ps = add_s(add_s(sv[0], sv[1]), add_s(sv[2], sv[3]));
      { float pa, pb2; pair32(ps, pa, pb2); ps = pa + pb2; } l += ps; }
    bf16x8 pb[2][2];
    { u32x4 w;
      w.x = cvt_pk_bf16(p0[0], p0[1]); w.y = cvt_pk_bf16(p0[2], p0[3]); w.z = cvt_pk_bf16(p0[4], p0[5]); w.w = cvt_pk_bf16(p0[6], p0[7]); pb[0][0] = *(bf16x8*)&w;
      w.x = cvt_pk_bf16(p0[8], p0[9]); w.y = cvt_pk_bf16(p0[10], p0[11]); w.z = cvt_pk_bf16(p0[12], p0[13]); w.w = cvt_pk_bf16(p0[14], p0[15]); pb[0][1] = *(bf16x8*)&w;
      w.x = cvt_pk_bf16(p1[0], p1[1]); w.y = cvt_pk_bf16(p1[2], p1[3]); w.z = cvt_pk_bf16(p1[4], p1[5]); w.w = cvt_pk_bf16(p1[6], p1[7]); pb[1][0] = *(bf16x8*)&w;
      w.x = cvt_pk_bf16(p1[8], p1[9]); w.y = cvt_pk_bf16(p1[10], p1[11]); w.z = cvt_pk_bf16(p1[12], p1[13]); w.w = cvt_pk_bf16(p1[14], p1[15]); pb[1][1] = *(bf16x8*)&w; }
    attn_pv<MODE>(st, lds, kbuf, pb, o);
}
template <int MODE> __device__ __forceinline__ void attn_core(const AttnState<MODE>& st, LAS unsigned char* lds, int tid, int lane, int t, u64 rowmask, const AttnSrc& S, u64 need, unsigned W, float c2,
                                                             int tmin, int tmax, u64 andmask, u64 ormask, f32x16 (&o)[4], float& m, float& l) {
#pragma unroll
    for (int cc = 0; cc < 4; ++cc)
#pragma unroll
        for (int i = 0; i < 16; ++i) o[cc][i] = 0.f;
    m = -1.0e30f; l = 0.f;
    __syncthreads();
    if (need == 0ull) return;
    if constexpr (MODE == 1) {
        int j = __builtin_ctzll(need); need &= need - 1ull;
        u32x4 kreg[2], vreg[2], k2reg = (u32x4){0u, 0u, 0u, 0u};
        attn_issue<MODE>(S, j, tid, kreg, k2reg, vreg, true);
        for (;;) {
            attn_write<MODE>(lds, 0, tid, kreg, k2reg, vreg, true);
            __syncthreads();
            bool more = (need != 0ull); int jn = 0;
            if (more) { jn = __builtin_ctzll(need); need &= need - 1ull; attn_issue<MODE>(S, jn, tid, kreg, k2reg, vreg, true); }
            attn_tile<MODE>(st, lds, 0, j, lane, t, rowmask, W, c2, tmin, tmax, andmask, ormask, o, m, l);
            if (!more) break;
            j = jn;
            attn_write<MODE>(lds, 1, tid, kreg, k2reg, vreg, true);
            __syncthreads();
            more = (need != 0ull);
            if (more) { jn = __builtin_ctzll(need); need &= need - 1ull; attn_issue<MODE>(S, jn, tid, kreg, k2reg, vreg, true); }
            attn_tile<MODE>(st, lds, 1, j, lane, t, rowmask, W, c2, tmin, tmax, andmask, ormask, o, m, l);
            if (!more) break;
            j = jn;
        }
        return;
    }
    u32x4 kA[2], vA[2], k2A = (u32x4){0u, 0u, 0u, 0u}, kB[2], vB[2], k2B = (u32x4){0u, 0u, 0u, 0u};
    int jA = __builtin_ctzll(need); need &= need - 1ull;
    attn_issue<MODE>(S, jA, tid, kA, k2A, vA, true);
    int jB = -1;
    if (need != 0ull) { jB = __builtin_ctzll(need); need &= need - 1ull; attn_issue<MODE>(S, jB, tid, kB, k2B, vB, true); }
    for (;;) {
        attn_write<MODE>(lds, 0, tid, kA, k2A, vA, true);
        __syncthreads();
        const int j0 = jA;
        if (need != 0ull) { jA = __builtin_ctzll(need); need &= need - 1ull; attn_issue<MODE>(S, jA, tid, kA, k2A, vA, true); } else jA = -1;
        attn_tile<MODE>(st, lds, 0, j0, lane, t, rowmask, W, c2, tmin, tmax, andmask, ormask, o, m, l);
        if (jB < 0) break;
        attn_write<MODE>(lds, 1, tid, kB, k2B, vB, true);
        __syncthreads();
        const int j1 = jB;
        if (need != 0ull) { jB = __builtin_ctzll(need); need &= need - 1ull; attn_issue<MODE>(S, jB, tid, kB, k2B, vB, true); } else jB = -1;
        attn_tile<MODE>(st, lds, 1, j1, lane, t, rowmask, W, c2, tmin, tmax, andmask, ormask, o, m, l);
        if (jA < 0) break;
    }
}
__device__ __forceinline__ void attn_store(const f32x16 (&o)[4], float l, int lane, bf16* orow) {
    const float inv = l > 0.f ? 1.0f / l : 0.f; const int hi = lane >> 5;
#pragma unroll
    for (int cc = 0; cc < 4; ++cc)
#pragma unroll
        for (int g4 = 0; g4 < 4; ++g4) { u32x2 w; w.x = cvt_pk_bf16(o[cc][4 * g4] * inv, o[cc][4 * g4 + 1] * inv); w.y = cvt_pk_bf16(o[cc][4 * g4 + 2] * inv, o[cc][4 * g4 + 3] * inv);
            *(u32x2*)(orow + 32 * cc + 8 * g4 + 4 * hi) = w; }
}

__device__ __forceinline__ void unit_signal(const Ctx& c, int idx) {
    asm volatile("s_waitcnt vmcnt(0)" ::: "memory");
    __syncthreads();
    if (fresh_tid(c.wv) == 0) { __builtin_amdgcn_fence(__ATOMIC_RELEASE, "agent"); asm volatile("s_waitcnt vmcnt(0)" ::: "memory"); (void)xb_add(c.ucnt + idx * 16, 1u); }
}
__device__ __forceinline__ void unit_wait(const Ctx& c, int idx, unsigned n) {
    if (fresh_tid(c.wv) == 0) { unsigned* bar = c.ctl + CW_BAR; XB_SPIN(xb_ld(c.ucnt + idx * 16) < n, bar); __builtin_amdgcn_fence(__ATOMIC_ACQUIRE, "agent"); asm volatile("s_waitcnt vmcnt(0)" ::: "memory"); }
    __syncthreads();
}
constexpr float C2_NSA = 0.08838834764831845f * 1.4426950408889634f;
constexpr float C2_MLA = 0.07216878364870322f * 1.4426950408889634f;

template <int KIND> __device__ __forceinline__ void nsa_unit(const Ctx& c, int idx) {
    const Lane L = mk_lane(c);
    const int chunk = idx >> 2, b = (idx >> 1) & 1, g = idx & 1;
    const int lane = L.lane, cq = lane & 31, ql = 8 * L.wave + (cq & 7), hh = cq >> 3, t = 64 * chunk + ql, head = 4 * g + hh;
    const bf16* Qn = (const bf16*)(c.ws + WS_QN);
    const size_t rowi = ((size_t)(b * SEQ + t) * 8 + head) * HD;
    AttnSrc S; S.K2 = nullptr; S.k2s = 0; S.ks = HD; S.vs = HD;
    const size_t kvoff = (size_t)(b * NG + g) * SEQ * HD;
    u64 rowmask = ~0ull, need;
    LAS u64* ctl64 = (LAS u64*)(c.lds + AT_CTL);
    if (KIND == 0) {
        S.K = (const bf16*)(c.ws + WS_NSAKV + 2 * NSAKV_ONE) + kvoff; S.V = (const bf16*)(c.ws + WS_NSAKV + 3 * NSAKV_ONE) + kvoff;
        unit_wait(c, idx, 2u);
        const u64* sm = (const u64*)(c.ws + WS_TAB + TAB_SELMASK) + (size_t)(b * NG + g) * SEQ;
        rowmask = sm[t];
        __syncthreads();
        if (L.tid < 64) { u64 mm = sm[64 * chunk + L.tid]; unsigned lo = (unsigned)mm, hi2 = (unsigned)(mm >> 32);
#pragma unroll
            for (int o2 = 1; o2 < 64; o2 <<= 1) { lo |= shx(lo, o2); hi2 |= shx(hi2, o2); }
            if (L.tid == 0) ctl64[0] = ((u64)hi2 << 32) | lo; }
        __syncthreads();
        need = ctl64[0];
        need &= (chunk == 63) ? ~0ull : ((1ull << (chunk + 1)) - 1ull);
    } else {
        S.K = (const bf16*)(c.ws + WS_NSAKV + 4 * NSAKV_ONE) + kvoff; S.V = (const bf16*)(c.ws + WS_NSAKV + 5 * NSAKV_ONE) + kvoff;
        const int lo = chunk - 8 > 0 ? chunk - 8 : 0;
        const u64 upto = (chunk == 63) ? ~0ull : ((1ull << (chunk + 1)) - 1ull);
        need = upto & ~((1ull << lo) - 1ull);
    }
    { const unsigned nlo = __builtin_amdgcn_readfirstlane((unsigned)need), nhi = __builtin_amdgcn_readfirstlane((unsigned)(need >> 32)); need = ((u64)nhi << 32) | nlo; }
    AttnState<0> st; attn_setup<0>(st, lane, Qn + rowi);
    f32x16 o[4]; float m, l;
    u64 andmask = ~0ull, ormask = ~0ull;
    if (KIND == 0) { unsigned lo = (unsigned)rowmask, hi2 = (unsigned)(rowmask >> 32);
#pragma unroll
        for (int o2 = 1; o2 < 64; o2 <<= 1) { lo &= shx(lo, o2); hi2 &= shx(hi2, o2); }
        andmask = ((u64)__builtin_amdgcn_readfirstlane(hi2) << 32) | __builtin_amdgcn_readfirstlane(lo);
        lo = (unsigned)rowmask; hi2 = (unsigned)(rowmask >> 32);
#pragma unroll
        for (int o2 = 1; o2 < 64; o2 <<= 1) { lo |= shx(lo, o2); hi2 |= shx(hi2, o2); }
        ormask = ((u64)__builtin_amdgcn_readfirstlane(hi2) << 32) | __builtin_amdgcn_readfirstlane(lo); }
    const int tmin = 64 * chunk + 8 * L.wave;
    attn_core<0>(st, c.lds, L.tid, lane, t, rowmask, S, need, KIND == 0 ? 0x7fffffffu : 512u, C2_NSA, tmin, tmin + 7, andmask, ormask, o, m, l);
    if (KIND == 1) attn_store(o, l, lane, (bf16*)(c.ws + WS_OW) + rowi);
    else {
        const float* gn = (const float*)(c.ws + WS_GNSA) + (size_t)(b * SEQ + t) * 24 + head;
        const float g0 = gn[0], g1 = gn[8] * (l > 0.f ? 1.0f / l : 0.f), g2 = gn[16]; const int hi = lane >> 5;
        const bf16* Oc = (const bf16*)(c.ws + WS_OC) + rowi; const bf16* Ow = (const bf16*)(c.ws + WS_OW) + rowi; bf16* Oa = (bf16*)(c.ws + WS_OA) + (size_t)(b * SEQ + t) * 2048 + head * HD;
#pragma unroll
        for (int cc = 0; cc < 4; ++cc)
#pragma unroll
            for (int g4 = 0; g4 < 4; ++g4) { const int d0 = 32 * cc + 8 * g4 + 4 * hi; const u32x2 wc = *(const u32x2*)(Oc + d0), ww = *(const u32x2*)(Ow + d0);
                const float r0 = g0 * bflo(wc.x) + g2 * bflo(ww.x) + g1 * o[cc][4 * g4], r1 = g0 * bfhi(wc.x) + g2 * bfhi(ww.x) + g1 * o[cc][4 * g4 + 1];
                const float r2 = g0 * bflo(wc.y) + g2 * bflo(ww.y) + g1 * o[cc][4 * g4 + 2], r3 = g0 * bfhi(wc.y) + g2 * bfhi(ww.y) + g1 * o[cc][4 * g4 + 3];
                u32x2 w; w.x = cvt_pk_bf16(r0, r1); w.y = cvt_pk_bf16(r2, r3); *(u32x2*)(Oa + d0) = w; }
    }
}
__device__ __forceinline__ void mla_unit(const Ctx& c, int idx) {
    { volatile LAS unsigned* MS = (volatile LAS unsigned*)(c.lds + MISC_OFF); const unsigned tag = (unsigned)(size_t)c.gcnt;
      if (MS[20] != tag) {
    cnt_wait(c.gcnt, (unsigned)c.G, c.ctl + CW_BAR, c.wv);
        if (fresh_tid(c.wv) == 0) MS[20] = tag; } }
    const Lane L = mk_lane(c);
    const int qb = idx >> 4, b = (idx >> 3) & 1, h = idx & 7;
    const int lane = L.lane, t = 256 * qb + 32 * L.wave + (lane & 31);
    const bf16* Qm = (const bf16*)(c.ws + WS_QM);
    AttnSrc S; S.K = (const bf16*)(c.ws + WS_KM) + ((size_t)(b * 8 + h) * SEQ) * HD; S.ks = HD;
    S.K2 = (const bf16*)(c.ws + WS_KR) + (size_t)b * SEQ * 64; S.k2s = 64;
    S.V = (const bf16*)(c.ws + WS_VM) + ((size_t)(b * 8 + h) * SEQ) * HD; S.vs = HD;
    const u64 need = (qb == 15) ? ~0ull : ((1ull << (4 * qb + 4)) - 1ull);
    AttnState<1> st; attn_setup<1>(st, lane, Qm + ((size_t)(b * SEQ + t) * 8 + h) * 192);
    f32x16 o[4]; float m, l;
    const int tmin = 256 * qb + 32 * L.wave;
    attn_core<1>(st, c.lds, L.tid, lane, t, ~0ull, S, need, 0x7fffffffu, C2_MLA, tmin, tmin + 31, ~0ull, ~0ull, o, m, l);
    attn_store(o, l, lane, (bf16*)(c.ws + WS_OA) + (size_t)(b * SEQ + t) * 2048 + 1024 + h * HD);
}
__device__ __forceinline__ void cmp_unit(const Ctx& c, int idx) {
    const Lane L = mk_lane(c);
    const int chunk = idx >> 2, b = (idx >> 1) & 1, g = idx & 1;
    cnt_wait(c.ccnt + (b * NG + g) * 16, 16u, c.ctl + CW_BAR, c.wv);
    const int lane = L.lane, cq = lane & 31, hi = lane >> 5, ql = 8 * L.wave + (cq & 7), hh = cq >> 3, t = 64 * chunk + ql, head = 4 * g + hh;
    const bf16* Qn = (const bf16*)(c.ws + WS_QN);
    const size_t rowi = ((size_t)(b * SEQ + t) * 8 + head) * HD;
    AttnSrc S; S.K2 = nullptr; S.k2s = 0; S.ks = HD; S.vs = HD;
    S.K = (const bf16*)(c.ws + WS_KC) + (size_t)(b * NG + g) * 256 * HD; S.V = (const bf16*)(c.ws + WS_VC) + (size_t)(b * NG + g) * 256 * HD;
    const int jmax = (4 * chunk + 2) >> 6;
    const u64 need = (1ull << (jmax + 1)) - 1ull;
    AttnState<2> st; attn_setup<2>(st, lane, Qn + rowi);
    f32x16 o[4]; float m, l;
    const int tmin = 64 * chunk + 8 * L.wave;
    attn_core<2>(st, c.lds, L.tid, lane, t, ~0ull, S, need, 0u, C2_NSA, tmin, tmin + 7, ~0ull, ~0ull, o, m, l);
    attn_store(o, l, lane, (bf16*)(c.ws + WS_OC) + rowi);
    LAS float* IMP = (LAS float*)(c.lds + AT_IMP);
    const float inv = l > 0.f ? 1.0f / l : 0.f, mb = m * C2_NSA;
    float carry = 0.f;
    __syncthreads();
    for (int j = 0; j <= jmax; ++j) {
        u32x4 kreg[2], vreg[2], k2reg = (u32x4){0u, 0u, 0u, 0u};
        attn_issue<2>(S, j, L.tid, kreg, k2reg, vreg, false);
        attn_write<2>(c.lds, j & 1, L.tid, kreg, k2reg, vreg, false);
        __syncthreads();
        f32x16 p0, p1;
        attn_scores<2>(st, c.lds, j & 1, j, lane, t, ~0ull, 0u, false, false, p0, p1);
#pragma unroll
        for (int i = 0; i < 16; ++i) { p0[i] = fexp2(fma_s(p0[i], C2_NSA, -mb)) * inv; p1[i] = fexp2(fma_s(p1[i], C2_NSA, -mb)) * inv; }
        float ol0[4], ol1[4];
#pragma unroll
        for (int gg = 0; gg < 4; ++gg) { ol0[gg] = shx(p0[4 * gg + 3], 32); ol1[gg] = shx(p1[4 * gg + 3], 32); }
        float im0[4], im1[4];
#pragma unroll
        for (int gg = 0; gg < 4; ++gg) {
            const float a0 = hi ? ol0[gg] : (gg == 0 ? carry : ol0[gg > 0 ? gg - 1 : 0]);
            const float a1 = hi ? ol1[gg] : (gg == 0 ? ol0[3] : ol1[gg > 0 ? gg - 1 : 0]);
            float v0 = (p0[4 * gg] + p0[4 * gg + 1]) + (p0[4 * gg + 2] + p0[4 * gg + 3]) + a0;
            float v1 = (p1[4 * gg] + p1[4 * gg + 1]) + (p1[4 * gg + 2] + p1[4 * gg + 3]) + a1;
            v0 += shx(v0, 8); v0 += shx(v0, 16); v1 += shx(v1, 8); v1 += shx(v1, 16);
            im0[gg] = v0; im1[gg] = v1; }
        carry = ol1[3];
        if (hh == 0) {
#pragma unroll
            for (int gg = 0; gg < 4; ++gg) { IMP[ql * 65 + 16 * j + 2 * gg + hi] = im0[gg]; IMP[ql * 65 + 16 * j + 8 + 2 * gg + hi] = im1[gg]; } }
    }
    __syncthreads();
    u64* sm = (u64*)(c.ws + WS_TAB + TAB_SELMASK) + (size_t)(b * NG + g) * SEQ;
    const int cur = chunk, jj = lane;
    for (int qi = 0; qi < 8; ++qi) {
        const int q = 8 * L.wave + qi;
        const bool cand = (jj >= 1) && (jj <= cur - 2);
        const float w = IMP[q * 65 + jj];
        const float v = cand ? w : 0.f;
        int rank = 0;
        for (int k = 1; k <= cur - 2; ++k) { const float vk = __builtin_bit_cast(float, __builtin_amdgcn_readlane(__builtin_bit_cast(int, w), k)); rank += (vk > v || (vk == v && k < jj)) ? 1 : 0; }
        const bool sel = (jj <= cur) && (jj == 0 || jj >= cur - 1 || (cand && rank < 13));
        const u64 mask = __ballot(sel);
        if (lane == 0) sm[64 * chunk + q] = mask;
    }
    __syncthreads();
}

__device__ __forceinline__ void nsa_merge_phase(const Ctx& c) {
    const Lane L = mk_lane(c);
    const bf16* Oc = (const bf16*)(c.ws + WS_OC); const bf16* Os = (const bf16*)(c.ws + WS_OS); const bf16* Ow = (const bf16*)(c.ws + WS_OW);
    const float* gn = (const float*)(c.ws + WS_GNSA); bf16* Oa = (bf16*)(c.ws + WS_OA);
    const int lane = L.lane, hh = lane >> 3;
    for (int row = L.gw; row < T; row += L.NGW) {
        const size_t off = (size_t)row * 1024 + lane * 16;
        const float g0 = gn[(size_t)row * 24 + hh], g1 = gn[(size_t)row * 24 + 8 + hh], g2 = gn[(size_t)row * 24 + 16 + hh];
        float a[16], b2[16], d[16];
        load16(Oc + off, a); load16(Os + off, b2); load16(Ow + off, d);
#pragma unroll
        for (int i = 0; i < 16; ++i) a[i] = g0 * a[i] + g1 * b2[i] + g2 * d[i];
        store16(Oa + off, a);
    }
}

__device__ __forceinline__ void moe_slots_phase(const Ctx& c) {
    const Lane L = mk_lane(c);
    const f32x4* route = (const f32x4*)(c.ws + WS_TAB + TAB_ROUTE);
    int* slot_tok = (int*)(c.ws + WS_TAB + TAB_SLOTTOK); float* slot_gate = (float*)(c.ws + WS_TAB + TAB_SLOTGATE); int* blk_exp = (int*)(c.ws + WS_TAB + TAB_BLKEXP);
    const bf16* hn = (const bf16*)(c.ws + WS_HN); bf16* Ag = (bf16*)(c.ws + WS_AG);
    LAS int* cnt = (LAS int*)(c.lds);
    const int per = T / c.G;
    const int t0 = c.vcu * per;
    __syncthreads();
    if (L.tid < 16) cnt[L.tid] = 0;
    __syncthreads();
    { int pre[8], tot[8];
#pragma unroll
      for (int e = 0; e < 8; ++e) { pre[e] = 0; tot[e] = 0; }
      for (int t = L.tid; t < T; t += 512) { const f32x4 r = route[t]; const int e0 = __float_as_int(r[0]), e1 = __float_as_int(r[1]); const bool before = t < t0;
#pragma unroll
          for (int e = 0; e < 8; ++e) { const int hit = (e0 == e ? 1 : 0) + (e1 == e ? 1 : 0); tot[e] += hit; pre[e] += before ? hit : 0; } }
#pragma unroll
      for (int e = 0; e < 8; ++e) {
#pragma unroll
          for (int o = 1; o < 64; o <<= 1) { pre[e] += shx(pre[e], o); tot[e] += shx(tot[e], o); }
          if (L.lane == 0) { atomicAdd((int*)&cnt[e], pre[e]); atomicAdd((int*)&cnt[8 + e], tot[e]); } } }
    __syncthreads();
    int pstart[8]; int acc = 0;
#pragma unroll
    for (int e = 0; e < 8; ++e) { pstart[e] = acc; acc += (cnt[8 + e] + 255) & ~255; }
    const int n_used = acc >> 8;
    int base[8];
#pragma unroll
    for (int e = 0; e < 8; ++e) base[e] = pstart[e] + cnt[e];
    for (int tc = 0; tc < per; tc += 32) {
        __syncthreads();
        { const int t = t0 + tc + (L.lane >> 1), k = L.lane & 1; const f32x4 r = route[t]; const int e = __float_as_int(k ? r[1] : r[0]); const float gt = k ? r[3] : r[2];
            int slot = 0;
#pragma unroll
            for (int ee = 0; ee < 8; ++ee) { const u64 bm = __ballot(e == ee); const int rk = __popcll(bm & ((1ull << L.lane) - 1ull)); if (e == ee) slot = base[ee] + rk; base[ee] += __popcll(bm); }
            if (L.wave == 0) { slot_tok[slot] = t; slot_gate[slot] = gt; cnt[16 + L.lane] = slot; ((int*)(c.ws + WS_TAB + TAB_TOKSLOT))[2 * t + k] = slot; } }
        __syncthreads();
        for (int i = 0; i < 8; ++i) { const int a2 = L.wave * 8 + i, t = t0 + tc + (a2 >> 1), slot = cnt[16 + a2];
            const u32x4* src = (const u32x4*)((const unsigned char*)hn + (size_t)t * DM); u32x4* dst = (u32x4*)((unsigned char*)Ag + (size_t)slot * DM);
            const u32x4 w0 = src[L.lane], w1 = src[L.lane + 64]; dst[L.lane] = w0; dst[L.lane + 64] = w1; }
    }
    if (c.vcu < 8) { const int e = c.vcu, n = cnt[8 + e], pe = (n + 255) & ~255; for (int i = n + L.tid; i < pe; i += 512) { slot_tok[pstart[e] + i] = -1; slot_gate[pstart[e] + i] = 0.f; } }
    if (c.vcu == 8 % c.G && L.tid < 73) { int v;
        if (L.tid == 72) v = n_used; else { const int s0 = L.tid * 256; v = 7;
#pragma unroll
            for (int e = 7; e >= 0; --e) if (s0 < pstart[e] + ((cnt[8 + e] + 255) & ~255)) v = e; }
        blk_exp[L.tid] = v; }
    __syncthreads();
}

__device__ __forceinline__ void moe_combine_phase(const Ctx& c, const bf16* x1, float* out) {
    const Lane L = mk_lane(c);
    const int* be = (const int*)(c.ws + WS_TAB + TAB_BLKEXP); const int nM = __builtin_amdgcn_readfirstlane(be[72]);
    int n_full, ks; pg8::Order::tail_params(nM * (DM / 256), c.G, DFF / 128, n_full, ks);
    const int* tokslot = (const int*)(c.ws + WS_TAB + TAB_TOKSLOT);
    const bf16* Y0 = (const bf16*)(c.ws + WS_Y0); const bf16* Yt = (const bf16*)(c.ws + WS_YT);
    for (int row = L.gw; row < T; row += L.NGW) {
        const int s0 = __builtin_amdgcn_readfirstlane(tokslot[2 * row]), s1 = __builtin_amdgcn_readfirstlane(tokslot[2 * row + 1]);
        f32x4* o = (f32x4*)(out + (size_t)row * DM) + L.lane; const u32x2* xi = (const u32x2*)(x1 + (size_t)row * DM) + L.lane;
#pragma unroll
        for (int j = 0; j < 8; ++j) {
            const u32x2 xw = xi[64 * j]; f32x4 v = (f32x4){bflo(xw.x), bfhi(xw.x), bflo(xw.y), bfhi(xw.y)};
#pragma unroll
            for (int q = 0; q < 2; ++q) { const int sl = q ? s1 : s0; { const u32x2 yw = ((const u32x2*)(Y0 + (size_t)sl * DM))[L.lane + 64 * j]; v += (f32x4){bflo(yw.x), bfhi(yw.x), bflo(yw.y), bfhi(yw.y)}; }
                const int wg = pg8::Order::tile_wgid(nM, DM / 256, sl >> 8, j);
                if (wg >= n_full) for (int p = 1; p < ks; ++p) { const u32x2 yw = ((const u32x2*)(Yt + (size_t)((wg - n_full) * (ks - 1) + p - 1) * 65536 + (size_t)(sl & 255) * 256))[L.lane]; v += (f32x4){bflo(yw.x), bfhi(yw.x), bflo(yw.y), bfhi(yw.y)}; } }
            o[64 * j] = v; }
    }
}

__device__ __forceinline__ bool phase_fence(Ctx& c) { asm volatile("" : "+s"(c.ws)); return true; }
__global__ void __launch_bounds__(512, 2) fwd_kernel(Args args) {
    extern __shared__ __attribute__((aligned(16))) unsigned char lds_raw[];
    Ctx c;
    c.lds = (LAS unsigned char*)lds_raw; c.ws = (GAS unsigned char*)args.ws; c.ctl = (unsigned*)(args.ws + WS_CTL);
    { int w = __builtin_amdgcn_readfirstlane((int)threadIdx.x >> 6); asm volatile("" : "+s"(w)); c.wv = w; }
    c.G = gridDim.x; { const int bx = blockIdx.x; c.vcu = (c.G % 8 == 0) ? (bx % 8) * (c.G / 8) + bx / 8 : bx; }
    volatile LAS unsigned* MISC = (volatile LAS unsigned*)(c.lds + MISC_OFF);
    for (int u = fresh_tid(c.wv); u < (LDS_BYTES - RING_BYTES) / 4; u += 512) ((LAS unsigned*)(c.lds + RING_BYTES))[u] = 0u;
    __syncthreads();
    XcdBarrier bar; bar.bar = c.ctl + CW_BAR; bar.x = 0; bar.st = nullptr;
#if MK_ONE_LAUNCH
    bar = xcd_barrier_post(c.ctl + CW_BAR, MISC + 8, c.wv);
#define GRID_BAR() xcd_barrier(bar)
#else
#define GRID_BAR() do { } while (0)
#endif
    const int lo = args.ph_lo, hi = args.ph_hi;
#if MK_ONE_LAUNCH
#define IN(k) (phase_fence(c), true)
#else
#define IN(k) (phase_fence(c), lo <= (k) && (k) < hi)
#endif
#define SEAM(k) do { if (IN(k) && IN((k) + 1)) GRID_BAR(); } while (0)
    LAS unsigned char* lds = c.lds;
    const int bx = (int)blockIdx.x;

    for (int rep = 0; rep < NREP(0); ++rep) { if (rep) GRID_BAR();
        if (IN(0)) { p0_prologue(args, c); norm_phase<false>(c, args.in[0], args.in[1], (bf16*)(c.ws + WS_HN), nullptr, nullptr); }
        }
    SEAM(0);

    for (int l = 0; l < 2; ++l) {
        const int P = 1 + 13 * l;
        unsigned char* wl = (unsigned char*)(c.ws + WS_WL + (size_t)l * WL_STRIDE);
        bf16* x1 = (l == 0) ? (bf16*)(c.ws + WS_X1) : (bf16*)(c.ws + WS_XA);
        bf16* hn = (bf16*)(c.ws + WS_HN);
        bf16* z = (bf16*)(c.ws + WS_Z);

        for (int rep = 0; rep < NREP(1); ++rep) { if (rep) GRID_BAR();
        if (IN(P + 1)) { pg8::Gemm g{hn, DM, (const bf16*)(wl + WL_IN), DM}; pg8::Order S; S.init(T / 256, DINP / 256, c.G, bx, DM); S.rot = (c.G == 256);
            const float* tabf = (const float*)(c.ws + WS_TAB);
            pg8::EpiInProj E{z, (l == 1) ? (const float*)(c.ws + WS_SSP + MiB) : nullptr, (bf16*)(c.ws + WS_QN), (unsigned char*)(c.ws + WS_NSAKV), (float*)(c.ws + WS_SSQ), (float*)(c.ws + WS_SSKV),
                             args.in[3] + l * 128, args.in[4] + l * 384, tabf + TAB_COS_TOK / 4, tabf + TAB_SIN_TOK / 4, (LAS float*)(lds + RING_BYTES + 2048),
                             (bf16*)(c.ws + WS_KR), (float*)(c.ws + WS_GNSA), args.in[16] + l * 64, tabf + TAB_COS_MLA / 4, tabf + TAB_SIN_MLA / 4};
            pg8::gemm_phase(lds, c.wv, g, S, E); }
        }
        SEAM(P + 1);
        for (int rep = 0; rep < NREP(7); ++rep) { if (rep) GRID_BAR();
        if (IN(P + 3)) {
            c.ccnt = c.ctl + CW_P3 + l * 128; c.gcnt = c.ccnt + 64;
            const bool part = (c.G >= 128);
            if (part) { if (bx < 64) compress_phase(c, args, l, bx, 64); } else compress_phase(c, args, l, c.vcu, c.G);
            { pg8::Gemm g{z + ZQA, DINP, (const bf16*)(wl + WL_QB), QLORA}; pg8::Order S; if (part) S.init(T / 256, 1536 / 256, c.G - 64, bx >= 64 ? bx - 64 : (1 << 20), QLORA); else S.init(T / 256, 1536 / 256, c.G, bx, QLORA); const float* tabf = (const float*)(c.ws + WS_TAB); pg8::EpiQb E{(bf16*)(c.ws + WS_QM), (const float*)(c.ws + WS_SSQ), args.in[13] + l * 128, args.in[14] + l * 64, tabf + TAB_COS_MLA / 4, tabf + TAB_SIN_MLA / 4, (LAS float*)(lds + RING_BYTES + 2048)}; pg8::gemm_phase(lds, c.wv, g, S, E); }
            { pg8::Gemm g{z + ZKVA, DINP, (const bf16*)(wl + WL_KVB), KVLORA}; pg8::Order S; S.init(T / 256, 2048 / 256, c.G, bx, KVLORA); pg8::EpiKvb E{(bf16*)(c.ws + WS_KM), (bf16*)(c.ws + WS_VM), (const float*)(c.ws + WS_SSKV), args.in[15] + l * 128, (LAS float*)(lds + RING_BYTES + 2048)}; pg8::gemm_phase(lds, c.wv, g, S, E); }
            if (MK_ONE_LAUNCH && REPEAT_MASK == 0) cnt_signal(c.gcnt, c.wv);
        }
        }
        if (!(MK_ONE_LAUNCH && REPEAT_MASK == 0)) SEAM(P + 3);
        for (int rep = 0; rep < NREP(9); ++rep) { if (rep) GRID_BAR();
        if (IN(P + 4)) {
            c.ucnt = c.ctl + CW_UNIT + l * 4096;
            for (int u = c.vcu; u < 256; u += c.G) { nsa_unit<1>(c, u); cmp_unit(c, 255 - u);
                asm volatile("s_waitcnt vmcnt(0)" ::: "memory"); __syncthreads();
                if (fresh_tid(c.wv) == 0) { __builtin_amdgcn_fence(__ATOMIC_RELEASE, "agent"); asm volatile("s_waitcnt vmcnt(0)" ::: "memory"); (void)xb_add(c.ucnt + u * 16, 1u); (void)xb_add(c.ucnt + (255 - u) * 16, 1u); } }
        }
        }
        if (!(MK_ONE_LAUNCH && REPEAT_MASK == 0)) SEAM(P + 4);
        for (int rep = 0; rep < NREP(4); ++rep) { if (rep) GRID_BAR();
        if (IN(P + 5)) {
            const int* order = (const int*)(c.ws + WS_TAB + TAB_ORDER);
            unsigned* qhead = c.ctl + CW_QUEUE + 64 * (l + 2 * rep);
            const int C = (l == 0) ? args.nch0 : args.nch_total - args.nch0, cbase = (l == 0) ? 0 : args.nch0;
            unsigned* chead = c.ctl + CW_QUEUE + 64 * (8 + l);
            unsigned* cact = c.ctl + CW_QUEUE + 64 * (12 + l);
            bool conv_left = true, attn_left = true;
            for (;;) {
                __syncthreads();
                if (fresh_tid(c.wv) == 0) { int r = -1;
                    if (conv_left) { const unsigned act = __hip_atomic_fetch_add(cact, 1u, __ATOMIC_RELAXED, __HIP_MEMORY_SCOPE_AGENT);
                        if (act < (unsigned)CONV_LIMIT || !attn_left) { const unsigned ch = __hip_atomic_fetch_add(chead, 1u, __ATOMIC_RELAXED, __HIP_MEMORY_SCOPE_AGENT); r = ch < (unsigned)C ? (int)ch : -2; }
                        if (r < 0) __hip_atomic_fetch_sub(cact, 1u, __ATOMIC_RELAXED, __HIP_MEMORY_SCOPE_AGENT); }
                    MISC[16] = (unsigned)r; }
                __syncthreads();
                const int r = (int)__builtin_amdgcn_readfirstlane(MISC[16]);
                if (r >= 0) { conv_chunk(args, c, cbase + r); __syncthreads(); if (fresh_tid(c.wv) == 0) __hip_atomic_fetch_sub(cact, 1u, __ATOMIC_RELAXED, __HIP_MEMORY_SCOPE_AGENT); continue; }
                if (r == -2) conv_left = false;
                if (attn_left) {
                    __syncthreads();
                    if (fresh_tid(c.wv) == 0) MISC[17] = __hip_atomic_fetch_add(qhead, 1u, __ATOMIC_RELAXED, __HIP_MEMORY_SCOPE_AGENT);
                    __syncthreads();
                    const int it = (int)__builtin_amdgcn_readfirstlane(MISC[17]);
                    if (it >= 512) attn_left = false;
                    else { const int id = __builtin_amdgcn_readfirstlane(order[it]), kind = id >> 8, idx = id & 255;
                        if (kind == 0) mla_unit(c, idx); else nsa_unit<0>(c, idx); }
                }
                if (!attn_left && !conv_left) break;
            }
        }
        }
        SEAM(P + 5);

        for (int rep = 0; rep < NREP(8); ++rep) { if (rep) GRID_BAR();
        if (IN(P + 7)) {
            { pg8::Gemm g{(const bf16*)(c.ws + WS_OA), 2048, (const bf16*)(wl + WL_PA), 2048}; pg8::Order S; S.init(T / 256, DM / 256, c.G, bx, 2048); pg8::EpiGateMix E{(bf16*)(c.ws + WS_MIX), z}; pg8::gemm_phase(lds, c.wv, g, S, E); }
        }
        }
        if (MK_ONE_LAUNCH && REPEAT_MASK == 0 && c.G == 256) {
            pg8::Order S7; S7.init(T / 256, DM / 256, c.G, bx, 2048); pg8::Unit u7; (void)S7.next(0, u7);
            unsigned* pc = c.ctl + CW_PANEL + (l * 32 + u7.pm) * 16;
            asm volatile("s_waitcnt vmcnt(0)" ::: "memory");
            __syncthreads();
            if (fresh_tid(c.wv) == 0) {
                __builtin_amdgcn_fence(__ATOMIC_RELEASE, "agent"); asm volatile("s_waitcnt vmcnt(0)" ::: "memory");
                (void)xb_add(pc, 1u);
                XB_SPIN(xb_ld(pc) < 8u, bar.bar);
                __builtin_amdgcn_fence(__ATOMIC_ACQUIRE, "agent"); asm volatile("s_waitcnt vmcnt(0)" ::: "memory"); }
            __syncthreads();
        } else SEAM(P + 7);
        for (int rep = 0; rep < NREP(3); ++rep) { if (rep) GRID_BAR();
        if (IN(P + 8)) { pg8::Gemm g{(const bf16*)(c.ws + WS_MIX), DM, (const bf16*)(wl + WL_OUT), DM}; pg8::Order S; S.init(T / 256, DM / 256, c.G, bx, DM);
            if (l == 0) { pg8::EpiRes<true> E{x1, args.in[0], args.in[20], hn, (float*)(c.ws + WS_SSP)}; pg8::gemm_phase(lds, c.wv, g, S, E); }
            else { pg8::EpiRes<false> E{x1, (const void*)(c.ws + WS_XA), args.in[20], nullptr, (float*)(c.ws + WS_SSP)}; pg8::gemm_phase(lds, c.wv, g, S, E); } }
        }
        SEAM(P + 8);
if (l == 1) {
            if (IN(P + 9)) norm_phase<true, true>(c, x1, args.in[20] + l * DM, hn, args.in[24], (float*)(c.ws + WS_TAB + TAB_ROUTE));
            SEAM(P + 9); }
        if (IN(P + 10)) { if (l == 1) moe_slots_phase(c); }
        if (l == 1) SEAM(P + 10);
        for (int rep = 0; rep < ((l == 0) ? NREP(5) : 1); ++rep) { if (rep) GRID_BAR();
        for (int rep2 = 0; rep2 < ((l == 1) ? NREP(6) : 1); ++rep2) { if (rep2) GRID_BAR();
        if (IN(P + 11)) {
            if (l == 0) { pg8::Gemm g{hn, DM, (const bf16*)(c.ws + WS_W13D), DM}; pg8::Order S; S.init(T / 256, 2 * DFF / 256, c.G, bx, DM); pg8::EpiSwiglu E{(void*)(c.ws + WS_H), (const float*)(c.ws + WS_SSP), 1.0f}; pg8::gemm_phase(lds, c.wv, g, S, E); }
            else { const int* be = (const int*)(c.ws + WS_TAB + TAB_BLKEXP); const int n_used = __builtin_amdgcn_readfirstlane(be[72]);
                pg8::Gemm g{(const bf16*)(c.ws + WS_AG), DM, (const bf16*)(c.ws + WS_W13E), DM}; pg8::Order S; S.init(n_used, 2 * DFF / 256, c.G, bx, DM, be, (size_t)56 * MiB, false, 1); pg8::EpiSwigluT<true> E{(void*)(c.ws + WS_H), nullptr, 1.0f / (F8_A_SCALE * (float)(1 << F8_W13_EXP))}; pg8::gemm_phase<pg8::EpiSwigluT<true>, true, true, 1>(lds, c.wv, g, S, E); }
        }
        }
        SEAM(P + 11);
        for (int rep3 = 0; rep3 < ((l == 1) ? NREP(10) : 1); ++rep3) { if (rep3) GRID_BAR();
        if (IN(P + 12)) {
            if (l == 0) { pg8::Gemm g{(const bf16*)(c.ws + WS_H), DFF, (const bf16*)(c.ws + WS_W2D), DFF}; pg8::Order S; S.init(T / 256, DM / 256, c.G, bx, DFF); pg8::EpiRes<false> E{(bf16*)(c.ws + WS_XA), (const void*)x1, args.in[1] + DM, hn, (float*)(c.ws + WS_SSP + MiB)}; pg8::gemm_phase(lds, c.wv, g, S, E); }
            else { const int* be = (const int*)(c.ws + WS_TAB + TAB_BLKEXP); const int n_used = __builtin_amdgcn_readfirstlane(be[72]);
                pg8::Gemm g{(const bf16*)(c.ws + WS_H), DFF, (const bf16*)(c.ws + WS_W2E), DFF}; pg8::Order S; S.init(n_used, DM / 256, c.G, bx, DFF, be, (size_t)28 * MiB, true, 1);
                pg8::EpiMoeDown E{(bf16*)(c.ws + WS_Y0), (bf16*)(c.ws + WS_YT), (const float*)(c.ws + WS_TAB + TAB_SLOTGATE), S.ks, 1.0f / (F8_H_SCALE * (float)(1 << F8_W2_EXP))}; pg8::gemm_phase<pg8::EpiMoeDown, true, true, 1>(lds, c.wv, g, S, E); }
        }
        }
        }
        if (l == 0) SEAM(P + 12);
    }
    SEAM(26);
    if (IN(27)) moe_combine_phase(c, (const bf16*)(c.ws + WS_XA), args.out);
}

extern "C" void kernel_launch(void* const* d_in, const int* in_sizes, int n_in, void* d_out, int out_size, void* d_ws, size_t ws_size, hipStream_t stream) {
    static int grid = 0;
    if (grid == 0) {
        if (n_in != 28 || out_size != T * DM || ws_size < WS_END2) { fprintf(stderr, "kernel_launch: unexpected shapes (n_in %d out %d ws %zu need %zu)\n", n_in, out_size, ws_size, (size_t)WS_END2); grid = -1; return; }
        int dev = 0, cus = 0, per_cu = 0;
        if (hipGetDevice(&dev) != hipSuccess || hipDeviceGetAttribute(&cus, hipDeviceAttributeMultiprocessorCount, dev) != hipSuccess) { grid = -1; return; }
        if (hipFuncSetAttribute((const void*)fwd_kernel, hipFuncAttributeMaxDynamicSharedMemorySize, LDS_BYTES) != hipSuccess) { fprintf(stderr, "kernel_launch: hipFuncSetAttribute failed\n"); grid = -1; return; }
        if (hipOccupancyMaxActiveBlocksPerMultiprocessor(&per_cu, (const void*)fwd_kernel, 512, LDS_BYTES) != hipSuccess || per_cu < 1) fprintf(stderr, "kernel_launch: occupancy query reports %d\n", per_cu);
        grid = cus;
    }
    if (grid < 0) return;
    Args a; memset(&a, 0, sizeof(a));
    for (int i = 0; i < 28; ++i) a.in[i] = (const float*)d_in[i];
    a.out = (float*)d_out; a.ws = (unsigned char*)d_ws;
    unsigned char* ws = (unsigned char*)d_ws;
    int nm = 0, item = 0;
    auto add = [&](const float* src, size_t dst_off, int K, int N, int mode, int ldd = 0, const float* gain = nullptr) { MatDesc& m = a.mat[nm++]; m.src = src; m.dst = (bf16*)(ws + dst_off); m.gain = gain; m.K = K; m.N = N; m.mode = mode; m.item0 = item; m.ldd = ldd ? ldd : K; m.pad = 0; item += (K / 64) * ((N + 31) / 32); };
    for (int l = 0; l < 2; ++l) {
        const size_t wl = WS_WL + l * WL_STRIDE;
        add(a.in[2] + (size_t)l * DM * DIN, wl + WL_IN, DM, DIN, 1);
        add(a.in[7] + (size_t)l * 4096 * 128, wl + WL_CK, 4096, 128, 0);
        add(a.in[8] + (size_t)l * 4096 * 128, wl + WL_CV, 4096, 128, 0);
        add(a.in[10] + (size_t)l * QLORA * 1536, wl + WL_QB, QLORA, 1536, 4, 0, a.in[9] + (size_t)l * QLORA);
        add(a.in[12] + (size_t)l * KVLORA * 2048, wl + WL_KVB, KVLORA, 2048, 0, 0, a.in[11] + (size_t)l * KVLORA);
        add(a.in[17] + (size_t)l * 1024 * DM, wl + WL_PA, 1024, DM, 0, 2048);
        add(a.in[18] + (size_t)l * 1024 * DM, wl + WL_PA + 2048, 1024, DM, 0, 2048);
        add(a.in[19] + (size_t)l * DM * DM, wl + WL_OUT, DM, DM, 0);
    }
    add(a.in[21], WS_W13D, DM, DFF, 2); add(a.in[22], WS_W13D, DM, DFF, 3); add(a.in[23], WS_W2D, DFF, DM, 0);
    for (int e = 0; e < NE; ++e) {
        add(a.in[25] + (size_t)e * DM * DFF, WS_W13E + (size_t)e * 56 * MiB, DM, DFF, 2); a.mat[nm - 1].pad = F8_W13_EXP;
        add(a.in[26] + (size_t)e * DM * DFF, WS_W13E + (size_t)e * 56 * MiB, DM, DFF, 3); a.mat[nm - 1].pad = F8_W13_EXP;
        add(a.in[27] + (size_t)e * DFF * DM, WS_W2E + (size_t)e * 28 * MiB, DFF, DM, 0); a.mat[nm - 1].pad = F8_W2_EXP;
    }
    a.total_items = item;
    a.bg_item0 = a.mat[5].item0;
    { const int nch = (item - a.bg_item0 + 127) / 128; const int need0 = (a.mat[19].item0 - a.bg_item0 + 127) / 128;
      int n0 = nch / 2; if (n0 < need0) n0 = need0; a.nch0 = n0; a.nch_total = nch; }
    if (hipMemsetAsync(ws + WS_CTL, 0, CTL_BYTES, stream) != hipSuccess) { fprintf(stderr, "kernel_launch: memset failed\n"); return; }
#if MK_ONE_LAUNCH
    a.ph_lo = 0; a.ph_hi = NPH;
    hipLaunchKernelGGL(fwd_kernel, dim3(grid), dim3(512), LDS_BYTES, stream, a);
#else
    for (int p = 0; p < NPH; ++p) { if (p == 11) continue; a.ph_lo = p; a.ph_hi = p + 1; hipLaunchKernelGGL(fwd_kernel, dim3(grid), dim3(512), LDS_BYTES, stream, a); }
#endif
    hipError_t le = hipGetLastError(); if (le != hipSuccess) fprintf(stderr, "kernel_launch: launch failed: %s\n", hipGetErrorName(le));
}
```
